# Optimizing an MI355X kernel written in HIP

```python
import math
import jax, jax.numpy as jnp
from jax import lax
import numpy as np

D_MODEL = 1024
BATCH = 4
SEQ = 4096
DEPTH = 1

HEAD_DIM = 64
N_Q_HEADS = 8
N_KV_HEADS = 2
GROUP = N_Q_HEADS // N_KV_HEADS
ATT_WIDTH = N_Q_HEADS * HEAD_DIM
KV_WIDTH = N_KV_HEADS * HEAD_DIM
WINDOW = 128
BLOCK = 128
CONV_WIDTH = D_MODEL // 2
CONV_K = 3
D_FF = 2816
N_BUCKETS = 32
MAX_DISTANCE = 128
LN_EPS = 1e-5
DEEPNORM_ALPHA = (2 * DEPTH) ** 0.25
DEEPNORM_BETA = (8 * DEPTH) ** -0.25
IN_PROJ_WIDTH = ATT_WIDTH + 2 * KV_WIDTH + 3 * CONV_WIDTH + 2 * D_MODEL
MASK_VALUE = -1e30

kernel_name = "hybrid_swa_shortconv_convffn_deepnorm"


def layer_norm(x, g, b):
    xf = x.astype(jnp.float32)
    mu = jnp.mean(xf, axis=-1, keepdims=True)
    var = jnp.mean(jnp.square(xf - mu), axis=-1, keepdims=True)
    return ((xf - mu) * lax.rsqrt(var + LN_EPS)).astype(x.dtype) * g + b


def dwconv3(x, w, b):
    xp = jnp.pad(x, ((0, 0), (1, 1), (0, 0)))
    return xp[:, :-2] * w[0] + xp[:, 1:-1] * w[1] + xp[:, 2:] * w[2] + b


def relative_bucket(rel):
    half = N_BUCKETS // 2
    max_exact = half // 2
    offset = jnp.where(rel > 0, half, 0)
    n = jnp.abs(rel)
    nf = jnp.maximum(n, 1).astype(jnp.float32)
    large = max_exact + (jnp.log(nf / max_exact) / math.log(MAX_DISTANCE / max_exact)
                         * (half - max_exact)).astype(jnp.int32)
    large = jnp.minimum(large, half - 1)
    return offset + jnp.where(n < max_exact, n, large)


def windowed_gqa(q, k, v, sink, rel_bias):
    bsz, seq = q.shape[0], q.shape[1]
    nb = seq // BLOCK
    qb = q.reshape(bsz, nb, BLOCK, N_KV_HEADS, GROUP, HEAD_DIM)

    def band(t):
        t = t.reshape(bsz, seq, N_KV_HEADS, HEAD_DIM)
        tp = jnp.pad(t, ((0, 0), (BLOCK, BLOCK), (0, 0), (0, 0)))
        tb = tp.reshape(bsz, nb + 2, BLOCK, N_KV_HEADS, HEAD_DIM)
        return jnp.concatenate([tb[:, :-2], tb[:, 1:-1], tb[:, 2:]], axis=2)

    kb, vb = band(k), band(v)
    scale = HEAD_DIM ** -0.5
    scores = jnp.einsum('bnqkgd,bnckd->bnkgqc', qb, kb).astype(jnp.float32) * scale

    qi = jnp.arange(BLOCK)[:, None]
    kc = jnp.arange(3 * BLOCK)[None, :]
    rel = kc - BLOCK - qi
    bias = rel_bias.astype(jnp.float32)[relative_bucket(rel)]
    bias = jnp.transpose(bias, (2, 0, 1)).reshape(N_KV_HEADS, GROUP, BLOCK, 3 * BLOCK)
    kpos = jnp.arange(nb)[:, None] * BLOCK - BLOCK + jnp.arange(3 * BLOCK)[None, :]
    valid = ((jnp.abs(rel) <= WINDOW)[None]
             & ((kpos >= 0) & (kpos < seq))[:, None, :])
    logits = jnp.where(valid[None, :, None, None], scores + bias, MASK_VALUE)

    sink_l = jnp.broadcast_to(sink.astype(jnp.float32).reshape(N_KV_HEADS, GROUP, 1, 1),
                              logits.shape[:-1] + (1,))
    probs = jax.nn.softmax(jnp.concatenate([logits, sink_l], axis=-1), axis=-1)[..., :-1]
    out = jnp.einsum('bnkgqc,bnckd->bnqkgd', probs.astype(vb.dtype), vb)
    return out.reshape(bsz, seq, ATT_WIDTH)


def hybrid_layer(h, w_in, b_gates, attn_sink, rel_bias, conv_w, conv_b,
                 w_att_branch, w_conv_branch, w_o, ln_mix_g, ln_mix_b,
                 w_ffn_up, ffn_conv_w, ffn_conv_b, w_ffn_down, ln_ffn_g, ln_ffn_b):
    proj = h @ w_in
    q, k, v, cb, cc, cx, gates = jnp.split(
        proj,
        np.cumsum([ATT_WIDTH, KV_WIDTH, KV_WIDTH, CONV_WIDTH, CONV_WIDTH, CONV_WIDTH]).tolist(),
        axis=-1)
    att = windowed_gqa(q, k, v, attn_sink, rel_bias)
    conv = cb * dwconv3(cc * cx, conv_w, conv_b)
    g = jax.nn.sigmoid(gates + b_gates)
    g_att, g_conv = g[..., :D_MODEL], g[..., D_MODEL:]
    merged = g_att * (att @ w_att_branch) + g_conv * (conv @ w_conv_branch)
    h = layer_norm(DEEPNORM_ALPHA * h + merged @ w_o, ln_mix_g, ln_mix_b)
    up = dwconv3(h @ w_ffn_up, ffn_conv_w, ffn_conv_b)
    a, u = up[..., :D_FF], up[..., D_FF:]
    ffn = (jax.nn.silu(a) * u) @ w_ffn_down
    return layer_norm(DEEPNORM_ALPHA * h + ffn, ln_ffn_g, ln_ffn_b)


def setup_inputs(seed: int = 0) -> dict:
    key = jax.random.key(seed)
    ks = jax.random.split(key, 24)
    f32 = jnp.float32
    L = DEPTH
    beta = DEEPNORM_BETA

    def nrm(k, shape, scale):
        return jax.random.normal(k, shape, f32) * scale

    col_scale = jnp.concatenate([
        jnp.ones((ATT_WIDTH + KV_WIDTH,), f32), jnp.full((KV_WIDTH,), beta, f32),
        jnp.ones((2 * CONV_WIDTH,), f32), jnp.full((CONV_WIDTH,), beta, f32),
        jnp.ones((2 * D_MODEL,), f32)])
    return {
        "x": nrm(ks[0], (BATCH, SEQ, D_MODEL), 1.0),
        "ln_in_g": 1.0 + nrm(ks[1], (D_MODEL,), 0.02),
        "ln_in_b": nrm(ks[2], (D_MODEL,), 0.02),
        "w_in": nrm(ks[3], (L, D_MODEL, IN_PROJ_WIDTH), D_MODEL ** -0.5) * col_scale,
        "b_gates": nrm(ks[4], (L, 2 * D_MODEL), 0.1),
        "attn_sink": nrm(ks[5], (L, N_Q_HEADS), 0.5),
        "rel_bias": nrm(ks[6], (N_BUCKETS, N_Q_HEADS), 0.2),
        "conv_w": nrm(ks[7], (L, CONV_K, CONV_WIDTH), CONV_K ** -0.5),
        "conv_b": nrm(ks[8], (L, CONV_WIDTH), 0.02),
        "w_att_branch": nrm(ks[9], (L, ATT_WIDTH, D_MODEL), beta * ATT_WIDTH ** -0.5),
        "w_conv_branch": nrm(ks[10], (L, CONV_WIDTH, D_MODEL), beta * CONV_WIDTH ** -0.5),
        "w_o": nrm(ks[11], (L, D_MODEL, D_MODEL), beta * D_MODEL ** -0.5),
        "ln_mix_g": 1.0 + nrm(ks[12], (L, D_MODEL), 0.02),
        "ln_mix_b": nrm(ks[13], (L, D_MODEL), 0.02),
        "w_ffn_up": nrm(ks[14], (L, D_MODEL, 2 * D_FF), beta * D_MODEL ** -0.5),
        "ffn_conv_w": nrm(ks[15], (L, CONV_K, 2 * D_FF), CONV_K ** -0.5),
        "ffn_conv_b": nrm(ks[16], (L, 2 * D_FF), 0.02),
        "w_ffn_down": nrm(ks[17], (L, D_FF, D_MODEL), beta * D_FF ** -0.5),
        "ln_ffn_g": 1.0 + nrm(ks[18], (L, D_MODEL), 0.02),
        "ln_ffn_b": nrm(ks[19], (L, D_MODEL), 0.02),
    }


def reference(x, ln_in_g, ln_in_b, w_in, b_gates, attn_sink, rel_bias, conv_w, conv_b,
              w_att_branch, w_conv_branch, w_o, ln_mix_g, ln_mix_b,
              w_ffn_up, ffn_conv_w, ffn_conv_b, w_ffn_down, ln_ffn_g, ln_ffn_b):
    h = layer_norm(x, ln_in_g, ln_in_b)
    for l in range(DEPTH):
        h = hybrid_layer(h, w_in[l], b_gates[l], attn_sink[l], rel_bias, conv_w[l], conv_b[l],
                         w_att_branch[l], w_conv_branch[l], w_o[l], ln_mix_g[l], ln_mix_b[l],
                         w_ffn_up[l], ffn_conv_w[l], ffn_conv_b[l], w_ffn_down[l],
                         ln_ffn_g[l], ln_ffn_b[l])
    return h
```

```cpp
#include <hip/hip_runtime.h>
#include <hip/hip_bf16.h>
#include <cstdio>
#include <cstdint>
#include <cmath>
namespace pg8 {
#define PG8_LAS __attribute__((address_space(3)))
typedef unsigned short bf16_t;
typedef short bf16x8 __attribute__((ext_vector_type(8)));
typedef float f32x4 __attribute__((ext_vector_type(4)));
typedef unsigned u32x4 __attribute__((ext_vector_type(4)));
typedef unsigned u32x2 __attribute__((ext_vector_type(2)));
constexpr int BM = 256, BK = 64, HALF = 128, HTB = HALF * BK * 2  , STAGE_BYTES = 8 * HTB, NXCD = 8, WGM = 8;

__host__ __device__ __forceinline__ int lds_byte(int r, int c) { const int st = (r >> 4) * 2 + (c >> 5), rr = r & 15, cc = c & 31, ob = rr * 64 + cc * 2; return st * 1024 + (ob ^ (((ob >> 9) & 1) << 5)); }
__host__ __device__ __forceinline__ void stage_rc(int b, int& R, int& C) { const int st = b / 1024, sb = b % 1024, swz = sb ^ (((sb >> 9) & 1) << 5); R = (st >> 1) * 16 + swz / 64; C = (st & 1) * 32 + (swz % 64) / 2; }
__host__ __device__ __forceinline__ int perm32(int rho) { const int n = rho >> 4, i = rho & 15; return 8 * (i >> 2) + 4 * n + (i & 3); }

struct Unit { int pm, pn; };
struct Gemm { const bf16_t* A; const bf16_t* Bt; int M, N, K; };

struct StaticOrder {
    int nM, nN, nwg, G, c;
    __host__ __device__ void init(int M, int N, int G_, int c_) { nM = M / BM; nN = N / BM; nwg = nM * nN; G = G_; c = c_; }
    __host__ __device__ bool next(int i, Unit& u) const {
        const long L = (long)i * G + c; if (L >= nwg) return false;
        int wgid = (int)L; { const int q = nwg / NXCD, r = nwg % NXCD, xcd = wgid % NXCD, off = wgid / NXCD; wgid = (xcd < r ? xcd * (q + 1) : r * (q + 1) + (xcd - r) * q) + off; }
        const int nig = WGM * nN, gid = wgid / nig, fm = gid * WGM, gsz = (nM - fm) < WGM ? (nM - fm) : WGM;
        u.pm = fm + ((wgid % nig) % gsz); u.pn = (wgid % nig) / gsz; return true;
    }
    __device__ __forceinline__ void a_ready(const Unit&) const {}
    __device__ __forceinline__ void done(const Unit&) const {}
};

__device__ __forceinline__ unsigned cvt_pk_bf16(float lo, float hi) { unsigned r; asm volatile("v_cvt_pk_bf16_f32 %0, %1, %2" : "=v"(r) : "v"(lo), "v"(hi)); return r; }
__device__ __forceinline__ float bf_lo(unsigned w) { return __uint_as_float(w << 16); }
__device__ __forceinline__ float bf_hi(unsigned w) { return __uint_as_float(w & 0xffff0000u); }
__device__ __forceinline__ float sigmoid_f(float x) { return __builtin_amdgcn_rcpf(1.0f + __builtin_amdgcn_exp2f(-1.4426950408889634f * x)); }

struct EpiF32 {
    static constexpr bool PERM = false, AFTER_DRAIN = false;
    float* C; int ldc;
    __device__ __forceinline__ void operator()(const f32x4 (&acc)[2][2][4][2], const Unit& u, int wr, int wc, int fr, int fq) const {
        const int row0 = u.pm * BM + wr * 64 + fr, col0 = u.pn * BM + wc * 32 + 4 * fq;
#pragma unroll
        for (int ai = 0; ai < 2; ++ai)
#pragma unroll
            for (int m = 0; m < 4; ++m) { float* rowp = C + (size_t)(row0 + ai * HALF + m * 16) * ldc + col0;
#pragma unroll
                for (int bj = 0; bj < 2; ++bj)
#pragma unroll
                    for (int n = 0; n < 2; ++n) *(f32x4*)(rowp + bj * HALF + n * 16) = acc[ai][bj][m][n]; }
    }
};
struct EpiBf16 {
    static constexpr bool PERM = true, AFTER_DRAIN = false;
    bf16_t* O; int ldc;
    __device__ __forceinline__ void operator()(const f32x4 (&acc)[2][2][4][2], const Unit& u, int wr, int wc, int fr, int fq) const {
        const int row0 = u.pm * BM + wr * 64 + fr, col0 = u.pn * BM + wc * 32 + 8 * fq;
#pragma unroll
        for (int ai = 0; ai < 2; ++ai)
#pragma unroll
            for (int m = 0; m < 4; ++m) { bf16_t* rowp = O + (size_t)(row0 + ai * HALF + m * 16) * ldc + col0;
#pragma unroll
                for (int bj = 0; bj < 2; ++bj) { const f32x4 v0 = acc[ai][bj][m][0], v1 = acc[ai][bj][m][1];
                    u32x4 w; w.x = cvt_pk_bf16(v0[0], v0[1]); w.y = cvt_pk_bf16(v0[2], v0[3]); w.z = cvt_pk_bf16(v1[0], v1[1]); w.w = cvt_pk_bf16(v1[2], v1[3]);
                    *(u32x4*)(rowp + bj * HALF) = w; } }
    }
};
struct EpiProj {
    static constexpr bool PERM = true, AFTER_DRAIN = false;
    bf16_t* PA; bf16_t* G; const float* bg;
    __device__ __forceinline__ void operator()(const f32x4 (&acc)[2][2][4][2], const Unit& u, int wr, int wc, int fr, int fq) const {
        const int row0 = u.pm * BM + wr * 64 + fr; const bool gate = u.pn >= 9;
        const int colt = gate ? (u.pn - 9) * BM : u.pn * BM, ldc = gate ? 2048 : 2304; bf16_t* base = gate ? G : PA;
        const int col0 = colt + wc * 32 + 8 * fq;
        f32x4 bv[2][2];
#pragma unroll
        for (int bj = 0; bj < 2; ++bj)
#pragma unroll
            for (int n = 0; n < 2; ++n) bv[bj][n] = gate ? *(const f32x4*)(bg + col0 + bj * HALF + 4 * n) : (f32x4){0.f, 0.f, 0.f, 0.f};
#pragma unroll
        for (int ai = 0; ai < 2; ++ai)
#pragma unroll
            for (int m = 0; m < 4; ++m) { bf16_t* rowp = base + (size_t)(row0 + ai * HALF + m * 16) * ldc + col0;
#pragma unroll
                for (int bj = 0; bj < 2; ++bj) { f32x4 v0 = acc[ai][bj][m][0] + bv[bj][0], v1 = acc[ai][bj][m][1] + bv[bj][1];
                    if (gate) {
#pragma unroll
                        for (int e = 0; e < 4; ++e) { v0[e] = sigmoid_f(v0[e]); v1[e] = sigmoid_f(v1[e]); } }
                    u32x4 w; w.x = cvt_pk_bf16(v0[0], v0[1]); w.y = cvt_pk_bf16(v0[2], v0[3]); w.z = cvt_pk_bf16(v1[0], v1[1]); w.w = cvt_pk_bf16(v1[2], v1[3]);
                    *(u32x4*)(rowp + bj * HALF) = w; } }
    }
};
struct EpiGateF32 {
    static constexpr bool PERM = true, AFTER_DRAIN = false;
    float* T; const bf16_t* G; int goff;
    __device__ __forceinline__ void operator()(const f32x4 (&acc)[2][2][4][2], const Unit& u, int wr, int wc, int fr, int fq) const {
        const int row0 = u.pm * BM + wr * 64 + fr, col0 = u.pn * BM + wc * 32 + 8 * fq;
#pragma unroll
        for (int ai = 0; ai < 2; ++ai)
#pragma unroll
            for (int m = 0; m < 4; ++m) { const size_t row = (size_t)(row0 + ai * HALF + m * 16);
#pragma unroll
                for (int bj = 0; bj < 2; ++bj) { const u32x4 g = *(const u32x4*)(G + row * 2048 + goff + col0 + bj * HALF);
                    const f32x4 v0 = acc[ai][bj][m][0], v1 = acc[ai][bj][m][1];
                    f32x4 o0, o1; o0[0] = v0[0] * bf_lo(g.x); o0[1] = v0[1] * bf_hi(g.x); o0[2] = v0[2] * bf_lo(g.y); o0[3] = v0[3] * bf_hi(g.y);
                    o1[0] = v1[0] * bf_lo(g.z); o1[1] = v1[1] * bf_hi(g.z); o1[2] = v1[2] * bf_lo(g.w); o1[3] = v1[3] * bf_hi(g.w);
                    float* tp = T + row * 1024 + col0 + bj * HALF; *(f32x4*)tp = o0; *(f32x4*)(tp + 4) = o1; } }
    }
};
struct EpiMerge {
    static constexpr bool PERM = true, AFTER_DRAIN = false;
    const float* T; const bf16_t* G; int goff; bf16_t* O;
    __device__ __forceinline__ void operator()(const f32x4 (&acc)[2][2][4][2], const Unit& u, int wr, int wc, int fr, int fq) const {
        const int row0 = u.pm * BM + wr * 64 + fr, col0 = u.pn * BM + wc * 32 + 8 * fq;
#pragma unroll
        for (int ai = 0; ai < 2; ++ai)
#pragma unroll
            for (int m = 0; m < 4; ++m) { const size_t row = (size_t)(row0 + ai * HALF + m * 16);
#pragma unroll
                for (int bj = 0; bj < 2; ++bj) { const u32x4 g = *(const u32x4*)(G + row * 2048 + goff + col0 + bj * HALF);
                    const float* tp = T + row * 1024 + col0 + bj * HALF; const f32x4 t0 = *(const f32x4*)tp, t1 = *(const f32x4*)(tp + 4);
                    const f32x4 v0 = acc[ai][bj][m][0], v1 = acc[ai][bj][m][1];
                    f32x4 o0, o1; o0[0] = t0[0] + v0[0] * bf_lo(g.x); o0[1] = t0[1] + v0[1] * bf_hi(g.x); o0[2] = t0[2] + v0[2] * bf_lo(g.y); o0[3] = t0[3] + v0[3] * bf_hi(g.y);
                    o1[0] = t1[0] + v1[0] * bf_lo(g.z); o1[1] = t1[1] + v1[1] * bf_hi(g.z); o1[2] = t1[2] + v1[2] * bf_lo(g.w); o1[3] = t1[3] + v1[3] * bf_hi(g.w);
                    u32x4 w; w.x = cvt_pk_bf16(o0[0], o0[1]); w.y = cvt_pk_bf16(o0[2], o0[3]); w.z = cvt_pk_bf16(o1[0], o1[1]); w.w = cvt_pk_bf16(o1[2], o1[3]);
                    *(u32x4*)(O + row * 1024 + col0 + bj * HALF) = w; } }
    }
};

template <class Epi, class Sched, bool ALIGN_EPI = false, bool SP2 = false>
__device__ __forceinline__ void gemm_phase(PG8_LAS unsigned char* lds, const Gemm g, const Sched& S, const Epi& E) {
    int tid_ = threadIdx.x; asm volatile("" : "+v"(tid_));
    const int tid = tid_, wid = __builtin_amdgcn_readfirstlane(tid >> 6), lane = tid & 63, wr = wid >> 2, wc = wid & 3, fr = lane & 15, fq = lane >> 4;
    const int K = g.K, nt = K / BK;
    unsigned voffA[2], voffB[2];
#pragma unroll
    for (int i = 0; i < 2; ++i) { int R, C; stage_rc(tid * 16 + i * 8192, R, C); const int Rb = Epi::PERM ? ((R & ~31) + perm32(R & 31)) : R;
        voffA[i] = (unsigned)(R * K + C) * 2u; voffB[i] = (unsigned)(Rb * K + C) * 2u; }
    const size_t kstep = (size_t)(BK * 2);
    const size_t hstep = (size_t)HALF * K * 2;
    const size_t tstep = 2 * hstep;
    const unsigned ldsw = (unsigned)wid * 1024u;
    const int aoff = lds_byte(wr * 64 + fr, fq * 8), boff = lds_byte(wc * 32 + fr, fq * 8);
#define PG8_SA(b, h) (((b) * 2 + (h)) * HTB)
#define PG8_SB(b, h) ((4 + (b) * 2 + (h)) * HTB)
#define PG8_STAGE(bufoff, gbase, voff) do { _Pragma("unroll") for (int _i = 0; _i < 2; ++_i) \
        __builtin_amdgcn_global_load_lds((const unsigned*)((const char*)(gbase) + (voff)[_i]), (PG8_LAS unsigned*)(lds + (bufoff) + ldsw + _i * 8192), 16, 0, 0); } while (0)
#define PG8_LDA(dst, b, h) do { _Pragma("unroll") for (int m = 0; m < 4; ++m) _Pragma("unroll") for (int k = 0; k < 2; ++k) dst[m][k] = *(const PG8_LAS bf16x8*)(lds + PG8_SA(b, h) + aoff + m * 2048 + k * 1024); } while (0)
#define PG8_LDB(dst, b, h) do { _Pragma("unroll") for (int n = 0; n < 2; ++n) _Pragma("unroll") for (int k = 0; k < 2; ++k) dst[n][k] = *(const PG8_LAS bf16x8*)(lds + PG8_SB(b, h) + boff + n * 2048 + k * 1024); } while (0)
#define PG8_MMA(ai, bj, At, Bt) do { __builtin_amdgcn_s_setprio(1); _Pragma("unroll") for (int m = 0; m < 4; ++m) _Pragma("unroll") for (int n = 0; n < 2; ++n) _Pragma("unroll") for (int k = 0; k < 2; ++k) \
        acc[ai][bj][m][n] = __builtin_amdgcn_mfma_f32_16x16x32_bf16(Bt[n][k], At[m][k], acc[ai][bj][m][n], 0, 0, 0); __builtin_amdgcn_s_setprio(0); } while (0)
#define PG8_WAIT_V(n) asm volatile("s_waitcnt vmcnt(" #n ")" ::: "memory")
#define PG8_WAIT_L(n) asm volatile("s_waitcnt lgkmcnt(" #n ")" ::: "memory")
#define PG8_BAR __builtin_amdgcn_s_barrier()
#define PG8_SCHED __builtin_amdgcn_sched_barrier(0)
    Unit cur, nxt; int ui = 0;
    if (!S.next(0, cur)) return;
    f32x4 acc[2][2][4][2];
#pragma unroll
    for (int a = 0; a < 2; ++a)
#pragma unroll
        for (int b = 0; b < 2; ++b)
#pragma unroll
            for (int m = 0; m < 4; ++m)
#pragma unroll
                for (int n = 0; n < 2; ++n) acc[a][b][m][n] = (f32x4){0.f, 0.f, 0.f, 0.f};
    bf16x8 At[4][2], B0[2][2], B1[2][2];
    const char* cA = (const char*)g.A + (size_t)cur.pm * tstep; const char* cB = (const char*)g.Bt + (size_t)cur.pn * tstep;
    S.a_ready(cur);
    if constexpr (SP2) {
        PG8_STAGE(PG8_SB(0, 0), cB, voffB); PG8_STAGE(PG8_SB(0, 1), cB + hstep, voffB); PG8_STAGE(PG8_SA(0, 0), cA, voffA); PG8_STAGE(PG8_SA(0, 1), cA + hstep, voffA);
        if (wr == 1) PG8_BAR;
        PG8_WAIT_V(2); PG8_BAR;
        PG8_STAGE(PG8_SB(1, 0), cB + kstep, voffB); PG8_STAGE(PG8_SA(1, 0), cA + kstep, voffA); PG8_STAGE(PG8_SB(1, 1), cB + hstep + kstep, voffB);
        PG8_WAIT_V(6); PG8_BAR;
    } else {
        PG8_STAGE(PG8_SB(0, 0), cB, voffB); PG8_STAGE(PG8_SA(0, 0), cA, voffA); PG8_STAGE(PG8_SB(0, 1), cB + hstep, voffB); PG8_STAGE(PG8_SA(0, 1), cA + hstep, voffA);
        if (wr == 1) PG8_BAR;
        PG8_WAIT_V(4); PG8_BAR;
        PG8_STAGE(PG8_SB(1, 0), cB + kstep, voffB); PG8_STAGE(PG8_SA(1, 0), cA + kstep, voffA); PG8_STAGE(PG8_SB(1, 1), cB + hstep + kstep, voffB);
        PG8_WAIT_V(6); PG8_BAR;
    }
    for (;;) {
        const bool has_next = S.next(ui + 1, nxt);
        const char* nA = has_next ? (const char*)g.A + (size_t)nxt.pm * tstep : cA; const char* nB = has_next ? (const char*)g.Bt + (size_t)nxt.pn * tstep : cB;
        for (int t = 0; t < nt; t += 2) {
            const bool last = (t == nt - 2);
            const char* a1 = cA + (size_t)(t + 1) * kstep;
            const char* a2 = last ? nA : cA + (size_t)(t + 2) * kstep; const char* b2 = last ? nB : cB + (size_t)(t + 2) * kstep;
            const char* a3 = a2 + kstep; const char* b3 = b2 + kstep;
            if (last && has_next) S.a_ready(nxt);
            if constexpr (SP2) {
            PG8_LDB(B0, 0, 0); PG8_LDB(B1, 0, 1); PG8_SCHED; PG8_LDA(At, 0, 0); PG8_STAGE(PG8_SA(1, 1), a1 + hstep, voffA);
            PG8_WAIT_V(8); PG8_WAIT_L(0); PG8_BAR; PG8_MMA(0, 0, At, B0); PG8_MMA(0, 1, At, B1); PG8_BAR; PG8_SCHED;
            PG8_LDA(At, 0, 1); PG8_STAGE(PG8_SB(0, 0), b2, voffB); PG8_STAGE(PG8_SB(0, 1), b2 + hstep, voffB); PG8_STAGE(PG8_SA(0, 0), a2, voffA);
            PG8_WAIT_V(8); PG8_WAIT_L(0); PG8_BAR; PG8_MMA(1, 0, At, B0); PG8_MMA(1, 1, At, B1); PG8_BAR; PG8_SCHED;
            PG8_LDB(B0, 1, 0); PG8_LDB(B1, 1, 1); PG8_SCHED; PG8_LDA(At, 1, 0); PG8_STAGE(PG8_SA(0, 1), a2 + hstep, voffA);
            PG8_WAIT_V(8); PG8_WAIT_L(0); PG8_BAR; PG8_MMA(0, 0, At, B0); PG8_MMA(0, 1, At, B1); PG8_BAR; PG8_SCHED;
            PG8_LDA(At, 1, 1); PG8_STAGE(PG8_SB(1, 0), b3, voffB); PG8_STAGE(PG8_SB(1, 1), b3 + hstep, voffB); PG8_STAGE(PG8_SA(1, 0), a3, voffA);
            PG8_WAIT_V(8); PG8_WAIT_L(0); PG8_BAR; PG8_MMA(1, 0, At, B0); PG8_MMA(1, 1, At, B1); PG8_BAR; PG8_SCHED;
            } else {
            PG8_LDB(B0, 0, 0); PG8_SCHED; PG8_LDA(At, 0, 0); PG8_STAGE(PG8_SA(1, 1), a1 + hstep, voffA);
            PG8_WAIT_L(8); PG8_BAR; PG8_WAIT_L(0); PG8_MMA(0, 0, At, B0); PG8_BAR; PG8_SCHED;
            PG8_LDB(B1, 0, 1); PG8_STAGE(PG8_SB(0, 0), b2, voffB);
            PG8_BAR; PG8_WAIT_L(0); PG8_MMA(0, 1, At, B1); PG8_BAR;
            PG8_LDA(At, 0, 1); PG8_STAGE(PG8_SA(0, 0), a2, voffA);
            PG8_BAR; PG8_WAIT_L(0); PG8_MMA(1, 0, At, B0); PG8_BAR; PG8_SCHED;
            PG8_STAGE(PG8_SB(0, 1), b2 + hstep, voffB);
            PG8_WAIT_V(6); PG8_BAR; PG8_MMA(1, 1, At, B1); PG8_BAR;
            PG8_LDB(B0, 1, 0); PG8_SCHED; PG8_LDA(At, 1, 0); PG8_STAGE(PG8_SA(0, 1), a2 + hstep, voffA);
            PG8_WAIT_L(8); PG8_BAR; PG8_WAIT_L(0); PG8_MMA(0, 0, At, B0); PG8_BAR; PG8_SCHED;
            PG8_LDB(B1, 1, 1); PG8_STAGE(PG8_SB(1, 0), b3, voffB);
            PG8_BAR; PG8_WAIT_L(0); PG8_MMA(0, 1, At, B1); PG8_BAR;
            PG8_LDA(At, 1, 1); PG8_STAGE(PG8_SA(1, 0), a3, voffA);
            PG8_BAR; PG8_WAIT_L(0); PG8_MMA(1, 0, At, B0); PG8_BAR; PG8_SCHED;
            PG8_STAGE(PG8_SB(1, 1), b3 + hstep, voffB);
            PG8_WAIT_V(6); PG8_BAR; PG8_MMA(1, 1, At, B1); PG8_BAR;
            }
        }
        if constexpr (ALIGN_EPI) { if (wr == 0) PG8_BAR; }
        if constexpr (!Epi::AFTER_DRAIN) { E(acc, cur, wr, wc, fr, fq); S.done(cur); }
        if (!has_next) break;
#pragma unroll
        for (int a = 0; a < 2; ++a)
#pragma unroll
            for (int b = 0; b < 2; ++b)
#pragma unroll
                for (int m = 0; m < 4; ++m)
#pragma unroll
                    for (int n = 0; n < 2; ++n) acc[a][b][m][n] = (f32x4){0.f, 0.f, 0.f, 0.f};
        cur = nxt; cA = nA; cB = nB; ++ui;
        if constexpr (ALIGN_EPI) { if (wr == 1) PG8_BAR; }
    }
    PG8_WAIT_V(0);
    if constexpr (!ALIGN_EPI) { if (wr == 0) PG8_BAR; }
    PG8_BAR;
    if constexpr (Epi::AFTER_DRAIN) { E.fused(acc, cur, wr, wc, fr, fq, lds, wid, lane); S.done(cur); }
#undef PG8_SA
#undef PG8_SB
#undef PG8_STAGE
#undef PG8_LDA
#undef PG8_LDB
#undef PG8_MMA
#undef PG8_WAIT_V
#undef PG8_WAIT_L
#undef PG8_BAR
#undef PG8_SCHED
}
}

constexpr int NB = 4, SEQ = 4096, D = 1024, M = NB * SEQ;
constexpr int NH = 8, HD = 64, ATT_W = 512, KV_W = 128, CONV_W = 512, DFF = 2816, NPROJ = 4352, NPA = 2304, NGATE = 2048;
constexpr int C_Q = 0, C_K = 512, C_V = 640, C_CB = 768, C_CC = 1280, C_CX = 1792;
constexpr float LN_EPS = 1e-5f;
constexpr float ALPHA = 1.189207115002721f;
constexpr int NWAVES = 8;

constexpr size_t MiB = 1u << 20;
constexpr size_t WS_CTL = 0, CTL_ZERO_BYTES = 1 * MiB;
constexpr size_t WS_WIN = 2 * MiB;
constexpr size_t WS_WA = 11 * MiB;
constexpr size_t WS_WC = 12 * MiB;
constexpr size_t WS_WO = 13 * MiB;
constexpr size_t WS_WUP = 15 * MiB;
constexpr size_t WS_WDN = 26 * MiB;
constexpr size_t WS_H0B = 32 * MiB;
constexpr size_t WS_PA = 64 * MiB;
constexpr size_t WS_G = 136 * MiB;
constexpr size_t WS_ATT = 200 * MiB;
constexpr size_t WS_CONV = 216 * MiB;
constexpr size_t WS_T1 = 32 * MiB;
constexpr size_t WS_MERGED = 96 * MiB;
constexpr size_t WS_MIX = 128 * MiB;
constexpr size_t WS_H1B = 224 * MiB;
constexpr size_t WS_UPH = 32 * MiB;
constexpr size_t WS_ACT = 120 * MiB;
constexpr size_t WS_FFN = 32 * MiB;
constexpr size_t WS_END = 256 * MiB;
constexpr int CW_BAR = 4096;

constexpr int RING_OFF = 0, RING_BYTES = 131072;
constexpr int LDSCTL_OFF = RING_BYTES, MISC_OFF = LDSCTL_OFF + 320;
constexpr int LDS_BYTES = 147456;

#define GAS __attribute__((address_space(1)))
#define LAS __attribute__((address_space(3)))
typedef unsigned short bf16;
typedef unsigned v4u __attribute__((ext_vector_type(4)));
typedef unsigned v2u __attribute__((ext_vector_type(2)));
typedef float f32x4 __attribute__((ext_vector_type(4)));
typedef float f32x16 __attribute__((ext_vector_type(16)));
typedef short bf16x8 __attribute__((ext_vector_type(8)));
typedef short s16x4 __attribute__((ext_vector_type(4)));
typedef GAS unsigned gu32;
typedef GAS unsigned long long gu64;
#define RLX_AGENT __ATOMIC_RELAXED, __HIP_MEMORY_SCOPE_AGENT
#define LDS_WAIT() asm volatile("s_waitcnt lgkmcnt(0)" ::: "memory")
#define VM_WAIT() asm volatile("s_waitcnt vmcnt(0)" ::: "memory")
__device__ __forceinline__ unsigned f2bf(float f) { unsigned u = __builtin_bit_cast(unsigned, f); return (u + 0x7fffu + ((u >> 16) & 1u)) >> 16; }
__device__ __forceinline__ unsigned pk2(float lo, float hi) { return f2bf(lo) | (f2bf(hi) << 16); }
__device__ __forceinline__ float bflo(unsigned w) { return __uint_as_float(w << 16); }
__device__ __forceinline__ float bfhi(unsigned w) { return __uint_as_float(w & 0xffff0000u); }

#define XB_TMO      128
#define XB_XCNT(j)  (256  + 64 * (j))
#define XB_XSUB(j)  (1280 + 64 * (j))
#define XB_XGEN(j)  (2304 + 64 * (j))
#define XB_TOP      3328
#define XB_TOPGEN   3392
#define XCD_BAR_WORDS 3456
#define XB_SPIN_CAP (1u << 18)

__device__ __forceinline__ unsigned xb_ld(unsigned* p)              { return __hip_atomic_load(p, __ATOMIC_RELAXED, __HIP_MEMORY_SCOPE_AGENT); }
__device__ __forceinline__ unsigned xb_add(unsigned* p, unsigned v) { return __hip_atomic_fetch_add(p, v, __ATOMIC_RELAXED, __HIP_MEMORY_SCOPE_AGENT); }
__device__ __forceinline__ unsigned xb_xcc_id() { return (unsigned)__builtin_amdgcn_s_getreg((3 << 11) | 20) & 0xFu; }
#define XB_SPIN(cond, bar) do { unsigned _sp = 0; while (cond) { __builtin_amdgcn_s_sleep(1); \
    if ((++_sp & 255u) == 0u) { if (xb_ld(&(bar)[XB_TMO])) break; if (_sp > XB_SPIN_CAP) { atomicAdd(&(bar)[XB_TMO], 1u); break; } } } } while (0)

struct XcdBarrier {
    unsigned* bar; unsigned x;
    volatile LAS unsigned* st;
};

__device__ __forceinline__ XcdBarrier xcd_barrier_post(unsigned* bar, volatile LAS unsigned* st) {
    XcdBarrier b; b.bar = bar; b.x = xb_xcc_id(); b.st = st;
    if (threadIdx.x == 0) (void)xb_add(&bar[XB_XCNT(b.x)], 1u);
    return b;
}
__device__ __forceinline__ void xcd_barrier_complete(unsigned* bar, unsigned x, unsigned& nloc, unsigned& nx) {
    const unsigned G = gridDim.x * gridDim.y * gridDim.z;
    unsigned sum, cnt, mine, sp = 0u;
    for (;;) {
        sum = 0u; cnt = 0u; mine = 0u;
#pragma unroll
        for (unsigned j = 0; j < 16; ++j) { const unsigned c = xb_ld(&bar[XB_XCNT(j)]); sum += c; cnt += (c > 0u) ? 1u : 0u; mine = (j == x) ? c : mine; }
        if (sum == G) break;
        __builtin_amdgcn_s_sleep(1);
        if ((++sp & 255u) == 0u) { if (xb_ld(&bar[XB_TMO])) break; if (sp > XB_SPIN_CAP) { atomicAdd(&bar[XB_TMO], 1u); break; } }
    }
    nloc = mine > 0u ? mine : 1u; nx = cnt > 0u ? cnt : 1u;
}

__device__ __forceinline__ void xcd_barrier(const XcdBarrier& b) {
    asm volatile("s_waitcnt vmcnt(0)" ::: "memory");
    __syncthreads();
    if (threadIdx.x == 0) {
        unsigned* bar = b.bar;
        __builtin_amdgcn_s_waitcnt(0);
        unsigned nloc = b.st[0], nx = b.st[1];
        if (nloc == 0u) { xcd_barrier_complete(bar, b.x, nloc, nx); b.st[0] = nloc; b.st[1] = nx; }
        const unsigned old = xb_add(&bar[XB_XSUB(b.x)], 1u);
        const unsigned gen = old / nloc;
        if (old + 1u == (gen + 1u) * nloc) {
            __builtin_amdgcn_fence(__ATOMIC_RELEASE, "agent");
            asm volatile("s_waitcnt vmcnt(0)" ::: "memory");
            const unsigned og = xb_add(&bar[XB_TOP], 1u);
            const unsigned tg = og / nx;
            if (og + 1u == (tg + 1u) * nx) xb_add(&bar[XB_TOPGEN], 1u);
            else XB_SPIN(xb_ld(&bar[XB_TOPGEN]) == tg, bar);
            __builtin_amdgcn_fence(__ATOMIC_ACQUIRE, "agent");
            xb_add(&bar[XB_XGEN(b.x)], 1u);
            asm volatile("s_waitcnt vmcnt(0)" ::: "memory");
        } else {
            XB_SPIN(xb_ld(&bar[XB_XGEN(b.x)]) == gen, bar);
            __builtin_amdgcn_fence(__ATOMIC_ACQUIRE, "agent");
            asm volatile("s_waitcnt vmcnt(0)" ::: "memory");
        }
    }
    __syncthreads();
}

__device__ __forceinline__ float wave_sum(float v) {
#pragma unroll
    for (int o = 1; o < 64; o <<= 1) v += __shfl_xor(v, o);
    return v;
}
__device__ __forceinline__ void p0_transpose_item(const float* W, int K, int N, bf16* WT, LAS float* scr, int item, int lane) {
    const int nblk = N / 32, kb = item / nblk, nb = item % nblk, k0 = 64 * kb, n0 = 32 * nb;
#pragma unroll 8
    for (int i = 0; i < 32; ++i) { const int kk = 2 * i + (lane >> 5); scr[kk * 33 + (lane & 31)] = W[(size_t)(k0 + kk) * N + n0 + (lane & 31)]; }
    LDS_WAIT(); asm volatile("" ::: "memory");
    const int c = lane & 7;
#pragma unroll
    for (int j = 0; j < 4; ++j) { const int n = (lane >> 3) + 8 * j; const LAS float* s = scr + (8 * c) * 33 + n;
        v4u o; o.x = pk2(s[0 * 33], s[1 * 33]); o.y = pk2(s[2 * 33], s[3 * 33]); o.z = pk2(s[4 * 33], s[5 * 33]); o.w = pk2(s[6 * 33], s[7 * 33]);
        *(GAS v4u*)(WT + (size_t)(n0 + n) * K + k0 + 8 * c) = o; }
    LDS_WAIT(); asm volatile("" ::: "memory");
}
__device__ __forceinline__ void row_stats(f32x4 (&v)[4], float& mean, float& rstd) {
    float s = 0.f;
#pragma unroll
    for (int j = 0; j < 4; ++j) s += (v[j].x + v[j].y) + (v[j].z + v[j].w);
    mean = wave_sum(s) * (1.f / D); float s2 = 0.f;
#pragma unroll
    for (int j = 0; j < 4; ++j) { v[j] = v[j] - mean; s2 += (v[j].x * v[j].x + v[j].y * v[j].y) + (v[j].z * v[j].z + v[j].w * v[j].w); }
    rstd = 1.f / sqrtf(wave_sum(s2) * (1.f / D) + LN_EPS);
}
__device__ __forceinline__ void ln0_row(const float* xrow, const float* g, const float* b, f32x4 (&v)[4], int lane) {
    const GAS f32x4* xr = (const GAS f32x4*)xrow + lane;
#pragma unroll
    for (int j = 0; j < 4; ++j) v[j] = xr[64 * j];
    float mean, rstd; row_stats(v, mean, rstd);
#pragma unroll
    for (int j = 0; j < 4; ++j) { const f32x4 gv = ((const GAS f32x4*)g)[lane + 64 * j], bv = ((const GAS f32x4*)b)[lane + 64 * j]; v[j] = v[j] * rstd * gv + bv; }
}
__device__ __forceinline__ void store_row_bf16(bf16* orow, const f32x4 (&v)[4], int lane) {
    GAS unsigned long long* o8 = (GAS unsigned long long*)orow + lane;
#pragma unroll
    for (int j = 0; j < 4; ++j) o8[64 * j] = (unsigned long long)pk2(v[j].x, v[j].y) | ((unsigned long long)pk2(v[j].z, v[j].w) << 32);
}

namespace att {
constexpr int VROWB = 144;
constexpr int WAVE_LDS = 32 * VROWB;
constexpr int TBL_OFF = 8 * WAVE_LDS;
constexpr int TBL_STRIDE = 264;
constexpr float LOG2E = 1.4426950408889634f;
__device__ __forceinline__ int crow(int r, int hi) { return (r & 3) + 8 * (r >> 2) + 4 * hi; }
__device__ __forceinline__ s16x4 vtr(const LAS unsigned char* p) {
    typedef short v4i16_t __attribute__((ext_vector_type(4)));
    return __builtin_bit_cast(s16x4, __builtin_amdgcn_ds_read_tr16_b64_v4i16((LAS v4i16_t*)p));
}
__device__ __forceinline__ void build_table(LAS float* tbl, const float* rel_bias, int tid) {
    for (int idx = tid; idx < NH * 257; idx += NWAVES * 64) {
        const int h = idx / 257, rr = idx % 257, rel = rr - 128, n = rel < 0 ? -rel : rel;
        int bucket;
        if (n < 8) bucket = n; else { int lg = 2 + (31 - __builtin_clz((unsigned)(n * n))); bucket = lg < 15 ? lg : 15; }
        if (rel > 0) bucket += 16;
        tbl[h * TBL_STRIDE + rr] = rel_bias[bucket * NH + h];
    }
}
__device__ __forceinline__ void attn_wave(int b, int q0, int h, const bf16* PA, bf16* O, const LAS float* tbl, LAS unsigned char* vlds, float sinkv, int lane) {
    const int r32 = lane & 31, hi = lane >> 5, kvh = h >> 2;
    const size_t qrow = (size_t)b * SEQ + q0 + r32;
    bf16x8 qf[4];
#pragma unroll
    for (int d0 = 0; d0 < 4; ++d0) qf[d0] = *(const GAS bf16x8*)(PA + qrow * NPA + C_Q + h * HD + 16 * d0 + 8 * hi);
    float m = sinkv, l = hi == 0 ? 1.f : 0.f;
    f32x16 o0, o1;
#pragma unroll
    for (int r = 0; r < 16; ++r) { o0[r] = 0.f; o1[r] = 0.f; }
    const int qpos = q0 + r32;
    const LAS float* tb = tbl + h * TBL_STRIDE + 128;
    const int tro = (4 * hi + ((lane & 15) >> 2)) * VROWB + (16 * ((lane >> 4) & 1) + 4 * (lane & 3)) * 2;
    for (int t = 0; t < 9; ++t) {
        const int key0 = q0 - 128 + 32 * t;
        if (key0 < 0 || key0 >= SEQ) continue;
        const size_t krow = (size_t)b * SEQ + key0 + r32;
        bf16x8 kf[4];
#pragma unroll
        for (int d0 = 0; d0 < 4; ++d0) kf[d0] = *(const GAS bf16x8*)(PA + krow * NPA + C_K + kvh * HD + 16 * d0 + 8 * hi);
        v4u vv[4];
#pragma unroll
        for (int i = 0; i < 4; ++i) { const int vr = 8 * i + (lane >> 3), ch = lane & 7;
            vv[i] = *(const GAS v4u*)(PA + ((size_t)b * SEQ + key0 + vr) * NPA + C_V + kvh * HD + ch * 8); }
        f32x16 p;
#pragma unroll
        for (int r = 0; r < 16; ++r) p[r] = 0.f;
#pragma unroll
        for (int d0 = 0; d0 < 4; ++d0) p = __builtin_amdgcn_mfma_f32_32x32x16_bf16(kf[d0], qf[d0], p, 0, 0, 0);
        asm volatile("" ::: "memory");
#pragma unroll
        for (int i = 0; i < 4; ++i) { const int vr = 8 * i + (lane >> 3), ch = lane & 7; *(LAS v4u*)(vlds + vr * VROWB + ch * 16) = vv[i]; }
        asm volatile("" ::: "memory");
        float mx = -INFINITY;
#pragma unroll
        for (int r = 0; r < 16; ++r) {
            const int rel = key0 + crow(r, hi) - qpos; const bool valid = (rel >= -128) && (rel <= 128);
            const int rc = rel < -128 ? -128 : (rel > 128 ? 128 : rel);
            const float s = valid ? p[r] * 0.125f + tb[rc] : -INFINITY;
            p[r] = s; mx = fmaxf(mx, s);
        }
        mx = fmaxf(mx, __shfl_xor(mx, 32));
        const float mnew = fmaxf(m, mx), alpha = __builtin_amdgcn_exp2f((m - mnew) * LOG2E); m = mnew;
        float ps = 0.f;
#pragma unroll
        for (int r = 0; r < 16; ++r) { p[r] = __builtin_amdgcn_exp2f((p[r] - mnew) * LOG2E); ps += p[r]; }
        l = l * alpha + ps;
#pragma unroll
        for (int r = 0; r < 16; ++r) { o0[r] *= alpha; o1[r] *= alpha; }
        v4u pw0, pw1;
        pw0.x = pk2(p[0], p[1]); pw0.y = pk2(p[2], p[3]); pw0.z = pk2(p[4], p[5]); pw0.w = pk2(p[6], p[7]);
        pw1.x = pk2(p[8], p[9]); pw1.y = pk2(p[10], p[11]); pw1.z = pk2(p[12], p[13]); pw1.w = pk2(p[14], p[15]);
        const bf16x8 pb0 = __builtin_bit_cast(bf16x8, pw0), pb1 = __builtin_bit_cast(bf16x8, pw1);
        LDS_WAIT();
#pragma unroll
        for (int s = 0; s < 2; ++s) {
#pragma unroll
            for (int db = 0; db < 2; ++db) {
                const LAS unsigned char* pa = vlds + tro + (16 * s) * VROWB + db * 64;
                const s16x4 lo = vtr(pa), hi4 = vtr(pa + 8 * VROWB);
                const bf16x8 vf = (bf16x8){lo[0], lo[1], lo[2], lo[3], hi4[0], hi4[1], hi4[2], hi4[3]};
                if (db == 0) o0 = __builtin_amdgcn_mfma_f32_32x32x16_bf16(vf, s == 0 ? pb0 : pb1, o0, 0, 0, 0);
                else         o1 = __builtin_amdgcn_mfma_f32_32x32x16_bf16(vf, s == 0 ? pb0 : pb1, o1, 0, 0, 0);
            }
        }
        asm volatile("" ::: "memory");
    }
    const float lt = l + __shfl_xor(l, 32), inv = 1.f / lt;
    bf16* orow = O + qrow * ATT_W + h * HD;
#pragma unroll
    for (int rr = 0; rr < 4; ++rr) {
        v2u w0, w1;
        w0.x = pk2(o0[4 * rr] * inv, o0[4 * rr + 1] * inv); w0.y = pk2(o0[4 * rr + 2] * inv, o0[4 * rr + 3] * inv);
        w1.x = pk2(o1[4 * rr] * inv, o1[4 * rr + 1] * inv); w1.y = pk2(o1[4 * rr + 2] * inv, o1[4 * rr + 3] * inv);
        *(GAS v2u*)(orow + 8 * rr + 4 * hi) = w0;
        *(GAS v2u*)(orow + 32 + 8 * rr + 4 * hi) = w1;
    }
}
}

struct Args { const float* in[20]; float* out; unsigned char* ws; };
__global__ void __launch_bounds__(NWAVES * 64, 2) hyb_fwd(Args args) {
    extern __shared__ __attribute__((aligned(16))) unsigned char lds_raw[];
    LAS unsigned char* lds = (LAS unsigned char*)lds_raw;
    volatile LAS unsigned* MISC = (volatile LAS unsigned*)(lds + MISC_OFF);
    const int tid = threadIdx.x, lane = tid & 63, wave = __builtin_amdgcn_readfirstlane(tid >> 6);
    const int G = gridDim.x, bx = blockIdx.x, vcu = (G % 8 == 0) ? (bx % 8) * (G / 8) + bx / 8 : bx;
    unsigned char* ws = args.ws;
    gu32* ctl = (gu32*)(ws + WS_CTL);
    const float* x = args.in[0]; float* out = args.out;
    bf16* WIN = (bf16*)(ws + WS_WIN); bf16* WA = (bf16*)(ws + WS_WA); bf16* WC = (bf16*)(ws + WS_WC); bf16* WO = (bf16*)(ws + WS_WO);
    bf16* WUP = (bf16*)(ws + WS_WUP); bf16* WDN = (bf16*)(ws + WS_WDN);
    bf16* H0B = (bf16*)(ws + WS_H0B); bf16* PA = (bf16*)(ws + WS_PA); bf16* GT = (bf16*)(ws + WS_G);
    bf16* ATT = (bf16*)(ws + WS_ATT); bf16* CONV = (bf16*)(ws + WS_CONV); float* T1 = (float*)(ws + WS_T1);
    bf16* MERGED = (bf16*)(ws + WS_MERGED); float* MIX = (float*)(ws + WS_MIX); bf16* H1B = (bf16*)(ws + WS_H1B);
    bf16* UPH = (bf16*)(ws + WS_UPH); bf16* ACT = (bf16*)(ws + WS_ACT); float* FFN = (float*)(ws + WS_FFN);

    for (int u = tid; u < (LDS_BYTES - LDSCTL_OFF) / 4; u += NWAVES * 64) ((LAS unsigned*)(lds + LDSCTL_OFF))[u] = 0u;
    __syncthreads();
    XcdBarrier bar = xcd_barrier_post((unsigned*)(ctl + CW_BAR), MISC + 8);
#define GRID_BAR() xcd_barrier(bar)
    const int gw = vcu * NWAVES + wave, NGW = G * NWAVES;

    {
        LAS float* scr = (LAS float*)(lds + RING_OFF + wave * 16384);
        constexpr int I_IN = (D / 64) * (NPROJ / 32), I_A = (ATT_W / 64) * (D / 32), I_C = (CONV_W / 64) * (D / 32), I_O = (D / 64) * (D / 32),
                      I_UP = (D / 64) * (2 * DFF / 32), I_DN = (DFF / 64) * (D / 32);
        constexpr int NITEMS = I_IN + I_A + I_C + I_O + I_UP + I_DN;
        for (int it = gw; it < NITEMS; it += NGW) {
            int r = it;
            if (r < I_IN) { p0_transpose_item(args.in[3], D, NPROJ, WIN, scr, r, lane); continue; } r -= I_IN;
            if (r < I_A) { p0_transpose_item(args.in[9], ATT_W, D, WA, scr, r, lane); continue; } r -= I_A;
            if (r < I_C) { p0_transpose_item(args.in[10], CONV_W, D, WC, scr, r, lane); continue; } r -= I_C;
            if (r < I_O) { p0_transpose_item(args.in[11], D, D, WO, scr, r, lane); continue; } r -= I_O;
            if (r < I_UP) { p0_transpose_item(args.in[14], D, 2 * DFF, WUP, scr, r, lane); continue; } r -= I_UP;
            p0_transpose_item(args.in[17], DFF, D, WDN, scr, r, lane);
        }
        for (int m = gw; m < M; m += NGW) { f32x4 v[4]; ln0_row(x + (size_t)m * D, args.in[1], args.in[2], v, lane); store_row_bf16(H0B + (size_t)m * D, v, lane); }
    }
    GRID_BAR();

    {
        pg8::Gemm g{H0B, WIN, M, NPROJ, D}; pg8::StaticOrder S; S.init(M, NPROJ, G, bx);
        pg8::EpiProj E{PA, GT, args.in[4]};
        pg8::gemm_phase<pg8::EpiProj, pg8::StaticOrder, true, true>(lds + RING_OFF, g, S, E);
    }
    GRID_BAR();

    {
        LAS float* tbl = (LAS float*)(lds + att::TBL_OFF);
        att::build_table(tbl, args.in[6], tid);
        __syncthreads();
        const float sinkv = args.in[5][wave];
        for (int u = vcu; u < NB * (SEQ / 32); u += G) {
            const int b = u / (SEQ / 32), q0 = (u % (SEQ / 32)) * 32;
            att::attn_wave(b, q0, wave, PA, ATT, tbl, lds + wave * att::WAVE_LDS, sinkv, lane);
        }
        const float* cw = args.in[7]; const float* cbias = args.in[8];
        for (int it = vcu * (NWAVES * 64) + tid; it < M * 64; it += G * NWAVES * 64) {
            const int row = it >> 6, ch = it & 63, t = row & (SEQ - 1);
            const bf16* base = PA + (size_t)row * NPA + 8 * ch;
            const v4u z = (v4u){0u, 0u, 0u, 0u};
            const v4u cb = *(const GAS v4u*)(base + C_CB), cc1 = *(const GAS v4u*)(base + C_CC), cx1 = *(const GAS v4u*)(base + C_CX);
            const v4u cc0 = t > 0 ? *(const GAS v4u*)(base - NPA + C_CC) : z, cx0 = t > 0 ? *(const GAS v4u*)(base - NPA + C_CX) : z;
            const v4u cc2 = t < SEQ - 1 ? *(const GAS v4u*)(base + NPA + C_CC) : z, cx2 = t < SEQ - 1 ? *(const GAS v4u*)(base + NPA + C_CX) : z;
            float w0[8], w1[8], w2[8], bb[8];
#pragma unroll
            for (int e = 0; e < 8; ++e) { w0[e] = cw[8 * ch + e]; w1[e] = cw[CONV_W + 8 * ch + e]; w2[e] = cw[2 * CONV_W + 8 * ch + e]; bb[e] = cbias[8 * ch + e]; }
            v4u o;
#pragma unroll
            for (int k = 0; k < 4; ++k) {
                const float p0l = bflo(cc0[k]) * bflo(cx0[k]), p0h = bfhi(cc0[k]) * bfhi(cx0[k]);
                const float p1l = bflo(cc1[k]) * bflo(cx1[k]), p1h = bfhi(cc1[k]) * bfhi(cx1[k]);
                const float p2l = bflo(cc2[k]) * bflo(cx2[k]), p2h = bfhi(cc2[k]) * bfhi(cx2[k]);
                const float yl = bflo(cb[k]) * (w0[2 * k] * p0l + w1[2 * k] * p1l + w2[2 * k] * p2l + bb[2 * k]);
                const float yh = bfhi(cb[k]) * (w0[2 * k + 1] * p0h + w1[2 * k + 1] * p1h + w2[2 * k + 1] * p2h + bb[2 * k + 1]);
                o[k] = pk2(yl, yh);
            }
            *(GAS v4u*)(CONV + (size_t)row * CONV_W + 8 * ch) = o;
        }
    }
    GRID_BAR();

    {
        pg8::StaticOrder S; S.init(M, D, G, bx);
        { pg8::Gemm g{ATT, WA, M, D, ATT_W}; pg8::EpiGateF32 E{T1, GT, 0};
          pg8::gemm_phase<pg8::EpiGateF32, pg8::StaticOrder, true, true>(lds + RING_OFF, g, S, E); }
        VM_WAIT(); __syncthreads();
        { pg8::Gemm g{CONV, WC, M, D, CONV_W}; pg8::EpiMerge E{T1, GT, 1024, MERGED};
          pg8::gemm_phase<pg8::EpiMerge, pg8::StaticOrder, true, true>(lds + RING_OFF, g, S, E); }
    }
    GRID_BAR();

    {
        pg8::Gemm g{MERGED, WO, M, D, D}; pg8::StaticOrder S; S.init(M, D, G, bx);
        pg8::EpiF32 E{MIX, D};
        pg8::gemm_phase<pg8::EpiF32, pg8::StaticOrder, true, true>(lds + RING_OFF, g, S, E);
    }
    GRID_BAR();

    for (int m = gw; m < M; m += NGW) {
        f32x4 v[4]; ln0_row(x + (size_t)m * D, args.in[1], args.in[2], v, lane);
        const GAS f32x4* mr = (const GAS f32x4*)(MIX + (size_t)m * D) + lane;
#pragma unroll
        for (int j = 0; j < 4; ++j) v[j] = v[j] * ALPHA + mr[64 * j];
        float mean, rstd; row_stats(v, mean, rstd);
        GAS f32x4* orow = (GAS f32x4*)(out + (size_t)m * D) + lane;
#pragma unroll
        for (int j = 0; j < 4; ++j) { const f32x4 gv = ((const GAS f32x4*)args.in[12])[lane + 64 * j], bv = ((const GAS f32x4*)args.in[13])[lane + 64 * j]; v[j] = v[j] * rstd * gv + bv; orow[64 * j] = v[j]; }
        store_row_bf16(H1B + (size_t)m * D, v, lane);
    }
    GRID_BAR();

    for (int hf = 0; hf < 2; ++hf) {
        {
            pg8::Gemm g{H1B + (size_t)hf * (M / 2) * D, WUP, M / 2, 2 * DFF, D}; pg8::StaticOrder S; S.init(M / 2, 2 * DFF, G, bx);
            pg8::EpiBf16 E{UPH, 2 * DFF};
            pg8::gemm_phase<pg8::EpiBf16, pg8::StaticOrder, true, true>(lds + RING_OFF, g, S, E);
        }
        GRID_BAR();
        {
            const float* fw = args.in[15]; const float* fb = args.in[16];
            constexpr int NCH = DFF / 8;
            for (int it = vcu * (NWAVES * 64) + tid; it < (M / 2) * NCH; it += G * NWAVES * 64) {
                const int lr = it / NCH, ch = it % NCH, t = lr & (SEQ - 1), j0 = 8 * ch;
                const bf16* base = UPH + (size_t)lr * (2 * DFF) + j0;
                const v4u z = (v4u){0u, 0u, 0u, 0u};
                const v4u a1 = *(const GAS v4u*)base, u1 = *(const GAS v4u*)(base + DFF);
                const v4u a0 = t > 0 ? *(const GAS v4u*)(base - 2 * DFF) : z, u0 = t > 0 ? *(const GAS v4u*)(base - 2 * DFF + DFF) : z;
                const v4u a2 = t < SEQ - 1 ? *(const GAS v4u*)(base + 2 * DFF) : z, u2 = t < SEQ - 1 ? *(const GAS v4u*)(base + 2 * DFF + DFF) : z;
                v4u o;
#pragma unroll
                for (int k = 0; k < 4; ++k) {
                    float r2[2];
#pragma unroll
                    for (int e = 0; e < 2; ++e) {
                        const int ca = j0 + 2 * k + e, cu = DFF + ca;
                        const float av0 = e ? bfhi(a0[k]) : bflo(a0[k]), av1 = e ? bfhi(a1[k]) : bflo(a1[k]), av2 = e ? bfhi(a2[k]) : bflo(a2[k]);
                        const float uv0 = e ? bfhi(u0[k]) : bflo(u0[k]), uv1 = e ? bfhi(u1[k]) : bflo(u1[k]), uv2 = e ? bfhi(u2[k]) : bflo(u2[k]);
                        const float ya = fw[ca] * av0 + fw[2 * DFF + ca] * av1 + fw[4 * DFF + ca] * av2 + fb[ca];
                        const float yu = fw[cu] * uv0 + fw[2 * DFF + cu] * uv1 + fw[4 * DFF + cu] * uv2 + fb[cu];
                        r2[e] = ya * pg8::sigmoid_f(ya) * yu;
                    }
                    o[k] = pk2(r2[0], r2[1]);
                }
                *(GAS v4u*)(ACT + ((size_t)hf * (M / 2) + lr) * DFF + j0) = o;
            }
        }
        GRID_BAR();
    }

    {
        pg8::Gemm g{ACT, WDN, M, D, DFF}; pg8::StaticOrder S; S.init(M, D, G, bx);
        pg8::EpiF32 E{FFN, D};
        pg8::gemm_phase<pg8::EpiF32, pg8::StaticOrder, true, true>(lds + RING_OFF, g, S, E);
    }
    GRID_BAR();

    for (int m = gw; m < M; m += NGW) {
        f32x4 v[4];
        GAS f32x4* orow = (GAS f32x4*)(out + (size_t)m * D) + lane;
        const GAS f32x4* fr = (const GAS f32x4*)(FFN + (size_t)m * D) + lane;
#pragma unroll
        for (int j = 0; j < 4; ++j) v[j] = orow[64 * j] * ALPHA + fr[64 * j];
        float mean, rstd; row_stats(v, mean, rstd);
#pragma unroll
        for (int j = 0; j < 4; ++j) { const f32x4 gv = ((const GAS f32x4*)args.in[18])[lane + 64 * j], bv = ((const GAS f32x4*)args.in[19])[lane + 64 * j]; orow[64 * j] = v[j] * rstd * gv + bv; }
    }
}

extern "C" void kernel_launch(void* const* d_in, const int* in_sizes, int n_in, void* d_out, int out_size, void* d_ws, size_t ws_size, hipStream_t stream) {
    static int grid = 0;
    if (grid == 0) {
        if (n_in != 20 || in_sizes[0] != M * D || out_size != M * D || ws_size < WS_END) { fprintf(stderr, "kernel_launch: unexpected shapes (n_in %d, in0 %d, out %d, ws %zu)\n", n_in, n_in > 0 ? in_sizes[0] : -1, out_size, ws_size); grid = -1; return; }
        int dev = 0, cus = 0;
        if (hipGetDevice(&dev) != hipSuccess || hipDeviceGetAttribute(&cus, hipDeviceAttributeMultiprocessorCount, dev) != hipSuccess) { grid = -1; return; }
        if (hipFuncSetAttribute((const void*)hyb_fwd, hipFuncAttributeMaxDynamicSharedMemorySize, LDS_BYTES) != hipSuccess) { fprintf(stderr, "kernel_launch: hipFuncSetAttribute failed\n"); grid = -1; return; }
        int per_cu = 0;
        if (hipOccupancyMaxActiveBlocksPerMultiprocessor(&per_cu, (const void*)hyb_fwd, NWAVES * 64, LDS_BYTES) != hipSuccess || per_cu < 1) fprintf(stderr, "kernel_launch: occupancy query reports %d\n", per_cu);
        (void)hipGetLastError();
        grid = cus;
    }
    if (grid < 0) return;
    if (hipMemsetAsync((char*)d_ws + WS_CTL, 0, CTL_ZERO_BYTES, stream) != hipSuccess) return;
    Args a{};
    for (int i = 0; i < 20; ++i) a.in[i] = (const float*)d_in[i];
    a.out = (float*)d_out; a.ws = (unsigned char*)d_ws;
    hipLaunchKernelGGL(hyb_fwd, dim3(grid), dim3(NWAVES * 64), LDS_BYTES, stream, a);
}
```

```cpp
#include <hip/hip_runtime.h>
#include <hip/hip_bf16.h>
#include <cstdio>
#include <cstdint>
#include <cmath>
namespace pg8 {
#define PG8_LAS __attribute__((address_space(3)))
typedef unsigned short bf16_t;
typedef short bf16x8 __attribute__((ext_vector_type(8)));
typedef float f32x4 __attribute__((ext_vector_type(4)));
typedef unsigned u32x4 __attribute__((ext_vector_type(4)));
typedef unsigned u32x2 __attribute__((ext_vector_type(2)));
constexpr int BM = 256, BK = 64, HALF = 128, HTB = HALF * BK * 2  , STAGE_BYTES = 8 * HTB, NXCD = 8, WGM = 8;

__host__ __device__ __forceinline__ int lds_byte(int r, int c) { const int st = (r >> 4) * 2 + (c >> 5), rr = r & 15, cc = c & 31, ob = rr * 64 + cc * 2; return st * 1024 + (ob ^ (((ob >> 9) & 1) << 5)); }
__host__ __device__ __forceinline__ void stage_rc(int b, int& R, int& C) { const int st = b / 1024, sb = b % 1024, swz = sb ^ (((sb >> 9) & 1) << 5); R = (st >> 1) * 16 + swz / 64; C = (st & 1) * 32 + (swz % 64) / 2; }
__host__ __device__ __forceinline__ int perm32(int rho) { const int n = rho >> 4, i = rho & 15; return 8 * (i >> 2) + 4 * n + (i & 3); }

struct Unit { int pm, pn; };
struct Gemm { const bf16_t* A; const bf16_t* Bt; int M, N, K; int mrows = 256; };

struct StaticOrder {
    int nM, nN, nwg, G, c;
    __host__ __device__ void init(int M, int N, int G_, int c_) { nM = M / BM; nN = N / BM; nwg = nM * nN; G = G_; c = c_; }
    __host__ __device__ void init_tiles(int nM_, int nN_, int G_, int c_) { nM = nM_; nN = nN_; nwg = nM * nN; G = G_; c = c_; }
    __host__ __device__ bool next(int i, Unit& u) const {
        const long L = (long)i * G + c; if (L >= nwg) return false;
        int wgid = (int)L; { const int q = nwg / NXCD, r = nwg % NXCD, xcd = wgid % NXCD, off = wgid / NXCD; wgid = (xcd < r ? xcd * (q + 1) : r * (q + 1) + (xcd - r) * q) + off; }
        const int nig = WGM * nN, gid = wgid / nig, fm = gid * WGM, gsz = (nM - fm) < WGM ? (nM - fm) : WGM;
        u.pm = fm + ((wgid % nig) % gsz); u.pn = (wgid % nig) / gsz; return true;
    }
    __device__ __forceinline__ void a_ready(const Unit&) const {}
    __device__ __forceinline__ void done(const Unit&) const {}
};

__device__ __forceinline__ unsigned cvt_pk_bf16(float lo, float hi) { unsigned r; asm volatile("v_cvt_pk_bf16_f32 %0, %1, %2" : "=v"(r) : "v"(lo), "v"(hi)); return r; }
__device__ __forceinline__ float bf_lo(unsigned w) { return __uint_as_float(w << 16); }
__device__ __forceinline__ float bf_hi(unsigned w) { return __uint_as_float(w & 0xffff0000u); }
__device__ __forceinline__ float sigmoid_f(float x) { return __builtin_amdgcn_rcpf(1.0f + __builtin_amdgcn_exp2f(-1.4426950408889634f * x)); }

struct EpiF32 {
    static constexpr bool PERM = false, AFTER_DRAIN = false;
    float* C; int ldc;
    __device__ __forceinline__ void operator()(const f32x4 (&acc)[2][2][4][2], const Unit& u, int wr, int wc, int fr, int fq) const {
        const int row0 = u.pm * BM + wr * 64 + fr, col0 = u.pn * BM + wc * 32 + 4 * fq;
#pragma unroll
        for (int ai = 0; ai < 2; ++ai)
#pragma unroll
            for (int m = 0; m < 4; ++m) { float* rowp = C + (size_t)(row0 + ai * HALF + m * 16) * ldc + col0;
#pragma unroll
                for (int bj = 0; bj < 2; ++bj)
#pragma unroll
                    for (int n = 0; n < 2; ++n) *(f32x4*)(rowp + bj * HALF + n * 16) = acc[ai][bj][m][n]; }
    }
};
struct EpiBf16 {
    static constexpr bool PERM = true, AFTER_DRAIN = false;
    bf16_t* O; int ldc;
    __device__ __forceinline__ void operator()(const f32x4 (&acc)[2][2][4][2], const Unit& u, int wr, int wc, int fr, int fq) const {
        const int row0 = u.pm * BM + wr * 64 + fr, col0 = u.pn * BM + wc * 32 + 8 * fq;
#pragma unroll
        for (int ai = 0; ai < 2; ++ai)
#pragma unroll
            for (int m = 0; m < 4; ++m) { bf16_t* rowp = O + (size_t)(row0 + ai * HALF + m * 16) * ldc + col0;
#pragma unroll
                for (int bj = 0; bj < 2; ++bj) { const f32x4 v0 = acc[ai][bj][m][0], v1 = acc[ai][bj][m][1];
                    u32x4 w; w.x = cvt_pk_bf16(v0[0], v0[1]); w.y = cvt_pk_bf16(v0[2], v0[3]); w.z = cvt_pk_bf16(v1[0], v1[1]); w.w = cvt_pk_bf16(v1[2], v1[3]);
                    *(u32x4*)(rowp + bj * HALF) = w; } }
    }
};
struct EpiProj {
    static constexpr bool PERM = true, AFTER_DRAIN = false;
    bf16_t* PA; bf16_t* G; const float* bg;
    __device__ __forceinline__ void operator()(const f32x4 (&acc)[2][2][4][2], const Unit& u, int wr, int wc, int fr, int fq) const {
        const int row0 = u.pm * BM + wr * 64 + fr; const bool gate = u.pn >= 9;
        const int colt = gate ? (u.pn - 9) * BM : u.pn * BM, ldc = gate ? 2048 : 2304; bf16_t* base = gate ? G : PA;
        const int col0 = colt + wc * 32 + 8 * fq;
        f32x4 bv[2][2];
#pragma unroll
        for (int bj = 0; bj < 2; ++bj)
#pragma unroll
            for (int n = 0; n < 2; ++n) bv[bj][n] = gate ? *(const f32x4*)(bg + col0 + bj * HALF + 4 * n) : (f32x4){0.f, 0.f, 0.f, 0.f};
#pragma unroll
        for (int ai = 0; ai < 2; ++ai)
#pragma unroll
            for (int m = 0; m < 4; ++m) { bf16_t* rowp = base + (size_t)(row0 + ai * HALF + m * 16) * ldc + col0;
#pragma unroll
                for (int bj = 0; bj < 2; ++bj) { f32x4 v0 = acc[ai][bj][m][0] + bv[bj][0], v1 = acc[ai][bj][m][1] + bv[bj][1];
                    if (gate) {
#pragma unroll
                        for (int e = 0; e < 4; ++e) { v0[e] = sigmoid_f(v0[e]); v1[e] = sigmoid_f(v1[e]); } }
                    u32x4 w; w.x = cvt_pk_bf16(v0[0], v0[1]); w.y = cvt_pk_bf16(v0[2], v0[3]); w.z = cvt_pk_bf16(v1[0], v1[1]); w.w = cvt_pk_bf16(v1[2], v1[3]);
                    *(u32x4*)(rowp + bj * HALF) = w; } }
    }
};
struct EpiGateF32 {
    static constexpr bool PERM = true, AFTER_DRAIN = false;
    float* T; const bf16_t* G; int goff;
    __device__ __forceinline__ void operator()(const f32x4 (&acc)[2][2][4][2], const Unit& u, int wr, int wc, int fr, int fq) const {
        const int row0 = u.pm * BM + wr * 64 + fr, col0 = u.pn * BM + wc * 32 + 8 * fq;
#pragma unroll
        for (int ai = 0; ai < 2; ++ai)
#pragma unroll
            for (int m = 0; m < 4; ++m) { const size_t row = (size_t)(row0 + ai * HALF + m * 16);
#pragma unroll
                for (int bj = 0; bj < 2; ++bj) { const u32x4 g = *(const u32x4*)(G + row * 2048 + goff + col0 + bj * HALF);
                    const f32x4 v0 = acc[ai][bj][m][0], v1 = acc[ai][bj][m][1];
                    f32x4 o0, o1; o0[0] = v0[0] * bf_lo(g.x); o0[1] = v0[1] * bf_hi(g.x); o0[2] = v0[2] * bf_lo(g.y); o0[3] = v0[3] * bf_hi(g.y);
                    o1[0] = v1[0] * bf_lo(g.z); o1[1] = v1[1] * bf_hi(g.z); o1[2] = v1[2] * bf_lo(g.w); o1[3] = v1[3] * bf_hi(g.w);
                    float* tp = T + row * 1024 + col0 + bj * HALF; *(f32x4*)tp = o0; *(f32x4*)(tp + 4) = o1; } }
    }
};
struct EpiMerge {
    static constexpr bool PERM = true, AFTER_DRAIN = false;
    const float* T; const bf16_t* G; int goff; bf16_t* O;
    __device__ __forceinline__ void operator()(const f32x4 (&acc)[2][2][4][2], const Unit& u, int wr, int wc, int fr, int fq) const {
        const int row0 = u.pm * BM + wr * 64 + fr, col0 = u.pn * BM + wc * 32 + 8 * fq;
#pragma unroll
        for (int ai = 0; ai < 2; ++ai)
#pragma unroll
            for (int m = 0; m < 4; ++m) { const size_t row = (size_t)(row0 + ai * HALF + m * 16);
#pragma unroll
                for (int bj = 0; bj < 2; ++bj) { const u32x4 g = *(const u32x4*)(G + row * 2048 + goff + col0 + bj * HALF);
                    const float* tp = T + row * 1024 + col0 + bj * HALF; const f32x4 t0 = *(const f32x4*)tp, t1 = *(const f32x4*)(tp + 4);
                    const f32x4 v0 = acc[ai][bj][m][0], v1 = acc[ai][bj][m][1];
                    f32x4 o0, o1; o0[0] = t0[0] + v0[0] * bf_lo(g.x); o0[1] = t0[1] + v0[1] * bf_hi(g.x); o0[2] = t0[2] + v0[2] * bf_lo(g.y); o0[3] = t0[3] + v0[3] * bf_hi(g.y);
                    o1[0] = t1[0] + v1[0] * bf_lo(g.z); o1[1] = t1[1] + v1[1] * bf_hi(g.z); o1[2] = t1[2] + v1[2] * bf_lo(g.w); o1[3] = t1[3] + v1[3] * bf_hi(g.w);
                    u32x4 w; w.x = cvt_pk_bf16(o0[0], o0[1]); w.y = cvt_pk_bf16(o0[2], o0[3]); w.z = cvt_pk_bf16(o1[0], o1[1]); w.w = cvt_pk_bf16(o1[2], o1[3]);
                    *(u32x4*)(O + row * 1024 + col0 + bj * HALF) = w; } }
    }
};


__device__ __forceinline__ int hidx_(int wr, int wc, int ai, int which, int bj, int n, int fq) { return (((((wr * 4 + wc) * 2 + ai) * 2 + which) * 2 + bj) * 2 + n) * 4 + fq; }
struct EpiUpConv {
    static constexpr bool PERM = true, AFTER_DRAIN = false;
    bf16_t* ACT; const float* fw; const float* fb; PG8_LAS unsigned char* halo;
    __device__ __forceinline__ void operator()(const f32x4 (&acc)[2][2][4][2], const Unit& u, int wr, int wc, int fr, int fq) const {
        constexpr int NF = 5632, DF = 2816, SEQM = 4095, MROWS = 16384;
        const int lane = fq * 16 + fr;
        PG8_LAS f32x4* H = (PG8_LAS f32x4*)halo;
#define HIDX(wr_, ai_, which_, bj_, n_) (hidx_((wr_), wc, (ai_), (which_), (bj_), (n_), fq))
        if (fr == 0) {
#pragma unroll
            for (int ai = 0; ai < 2; ++ai)
#pragma unroll
                for (int bj = 0; bj < 2; ++bj)
#pragma unroll
                    for (int n = 0; n < 2; ++n) H[HIDX(wr, ai, 0, bj, n)] = acc[ai][bj][0][n]; }
        if (fr == 15) {
#pragma unroll
            for (int ai = 0; ai < 2; ++ai)
#pragma unroll
                for (int bj = 0; bj < 2; ++bj)
#pragma unroll
                    for (int n = 0; n < 2; ++n) H[HIDX(wr, ai, 1, bj, n)] = acc[ai][bj][3][n]; }
        asm volatile("s_waitcnt lgkmcnt(0)" ::: "memory"); __builtin_amdgcn_s_barrier(); asm volatile("" ::: "memory");
        const int j0 = u.pn * 128 + wc * 32 + 8 * fq;
        const int src_p = (lane & 48) | ((fr + 15) & 15), src_n = (lane & 48) | ((fr + 1) & 15);
        const int grow0 = 254 * u.pm - 1;
        const f32x4 z4 = (f32x4){0.f, 0.f, 0.f, 0.f};
#pragma unroll
        for (int n = 0; n < 2; ++n) {
#pragma unroll
            for (int ai = 0; ai < 2; ++ai) {
                const bool hp_ok = !(ai == 0 && wr == 0), hn_ok = !(ai == 1 && wr == 1);
                const int ai_p = (wr == 1 || ai == 0) ? ai : ai - 1, ai_n = (wr == 0 || ai == 1) ? ai : ai + 1;
                f32x4 sa[4];
#pragma unroll
                for (int bj = 0; bj < 2; ++bj) {
                    const float* fwc = fw + bj * DF + j0 + 4 * n;
                    const f32x4 w0 = *(const f32x4*)fwc, w1 = *(const f32x4*)(fwc + NF), w2 = *(const f32x4*)(fwc + 2 * NF), bb = *(const f32x4*)(fb + bj * DF + j0 + 4 * n);
                    const f32x4 hp = hp_ok ? H[HIDX(wr ^ 1, ai_p, 1, bj, n)] : z4, hn = hn_ok ? H[HIDX(wr ^ 1, ai_n, 0, bj, n)] : z4;
#pragma unroll
                    for (int m = 0; m < 4; ++m) {
                        const f32x4 x = acc[ai][bj][m][n];
                        const f32x4 sp = (m > 0 && fr == 15) ? acc[ai][bj][m > 0 ? m - 1 : 0][n] : x, sn = (m < 3 && fr == 0) ? acc[ai][bj][m < 3 ? m + 1 : 3][n] : x;
                        f32x4 pv, nv;
#pragma unroll
                        for (int e = 0; e < 4; ++e) { pv[e] = __shfl(sp[e], src_p); nv[e] = __shfl(sn[e], src_n); }
                        if (m == 0 && fr == 0) pv = hp;
                        if (m == 3 && fr == 15) nv = hn;
                        const int lr = 128 * ai + 64 * wr + 16 * m + fr, gr = grow0 + lr, t = gr & SEQM;
                        if (t == 0) pv = z4;
                        if (t == SEQM) nv = z4;
                        const f32x4 y = w0 * pv + w1 * x + w2 * nv + bb;
                        if (bj == 0) {
#pragma unroll
                            for (int e = 0; e < 4; ++e) sa[m][e] = y[e] * sigmoid_f(y[e]);
                        } else {
                            const f32x4 o = sa[m] * y;
                            u32x2 w; w.x = cvt_pk_bf16(o[0], o[1]); w.y = cvt_pk_bf16(o[2], o[3]);
                            if (lr >= 1 && lr <= 254 && gr < MROWS) *(u32x2*)(ACT + (size_t)gr * DF + j0 + 4 * n) = w;
                        }
                    }
                }
            }
        }
#undef HIDX
    }
};
template <class Epi, class Sched, bool ALIGN_EPI = false, bool SP2 = false>
__device__ __forceinline__ void gemm_phase(PG8_LAS unsigned char* lds, const Gemm g, const Sched& S, const Epi& E) {
    int tid_ = threadIdx.x; asm volatile("" : "+v"(tid_));
    const int tid = tid_, wid = __builtin_amdgcn_readfirstlane(tid >> 6), lane = tid & 63, wr = wid >> 2, wc = wid & 3, fr = lane & 15, fq = lane >> 4;
    const int K = g.K, nt = K / BK;
    unsigned voffA[2], voffB[2];
#pragma unroll
    for (int i = 0; i < 2; ++i) { int R, C; stage_rc(tid * 16 + i * 8192, R, C); const int Rb = Epi::PERM ? ((R & ~31) + perm32(R & 31)) : R;
        voffA[i] = (unsigned)(R * K + C) * 2u; voffB[i] = (unsigned)(Rb * K + C) * 2u; }
    const size_t kstep = (size_t)(BK * 2);
    const size_t hstep = (size_t)HALF * K * 2;
    const size_t tstep = 2 * hstep;
    const size_t tstepA = (size_t)g.mrows * K * 2;
    const unsigned ldsw = (unsigned)wid * 1024u;
    const int aoff = lds_byte(wr * 64 + fr, fq * 8), boff = lds_byte(wc * 32 + fr, fq * 8);
#define PG8_SA(b, h) (((b) * 2 + (h)) * HTB)
#define PG8_SB(b, h) ((4 + (b) * 2 + (h)) * HTB)
#define PG8_STAGE(bufoff, gbase, voff) do { _Pragma("unroll") for (int _i = 0; _i < 2; ++_i) \
        __builtin_amdgcn_global_load_lds((const unsigned*)((const char*)(gbase) + (voff)[_i]), (PG8_LAS unsigned*)(lds + (bufoff) + ldsw + _i * 8192), 16, 0, 0); } while (0)
#define PG8_LDA(dst, b, h) do { _Pragma("unroll") for (int m = 0; m < 4; ++m) _Pragma("unroll") for (int k = 0; k < 2; ++k) dst[m][k] = *(const PG8_LAS bf16x8*)(lds + PG8_SA(b, h) + aoff + m * 2048 + k * 1024); } while (0)
#define PG8_LDB(dst, b, h) do { _Pragma("unroll") for (int n = 0; n < 2; ++n) _Pragma("unroll") for (int k = 0; k < 2; ++k) dst[n][k] = *(const PG8_LAS bf16x8*)(lds + PG8_SB(b, h) + boff + n * 2048 + k * 1024); } while (0)
#define PG8_MMA(ai, bj, At, Bt) do { __builtin_amdgcn_s_setprio(1); _Pragma("unroll") for (int m = 0; m < 4; ++m) _Pragma("unroll") for (int n = 0; n < 2; ++n) _Pragma("unroll") for (int k = 0; k < 2; ++k) \
        acc[ai][bj][m][n] = __builtin_amdgcn_mfma_f32_16x16x32_bf16(Bt[n][k], At[m][k], acc[ai][bj][m][n], 0, 0, 0); __builtin_amdgcn_s_setprio(0); } while (0)
#define PG8_WAIT_V(n) asm volatile("s_waitcnt vmcnt(" #n ")" ::: "memory")
#define PG8_WAIT_L(n) asm volatile("s_waitcnt lgkmcnt(" #n ")" ::: "memory")
#define PG8_BAR __builtin_amdgcn_s_barrier()
#define PG8_SCHED __builtin_amdgcn_sched_barrier(0)
    Unit cur, nxt; int ui = 0;
    if (!S.next(0, cur)) return;
    f32x4 acc[2][2][4][2];
#pragma unroll
    for (int a = 0; a < 2; ++a)
#pragma unroll
        for (int b = 0; b < 2; ++b)
#pragma unroll
            for (int m = 0; m < 4; ++m)
#pragma unroll
                for (int n = 0; n < 2; ++n) acc[a][b][m][n] = (f32x4){0.f, 0.f, 0.f, 0.f};
    bf16x8 At[4][2], B0[2][2], B1[2][2];
    const char* cA = (const char*)g.A + (size_t)cur.pm * tstepA; const char* cB = (const char*)g.Bt + (size_t)cur.pn * tstep;
    S.a_ready(cur);
    if constexpr (SP2) {
        PG8_STAGE(PG8_SB(0, 0), cB, voffB); PG8_STAGE(PG8_SB(0, 1), cB + hstep, voffB); PG8_STAGE(PG8_SA(0, 0), cA, voffA); PG8_STAGE(PG8_SA(0, 1), cA + hstep, voffA);
        if (wr == 1) PG8_BAR;
        PG8_WAIT_V(2); PG8_BAR;
        PG8_STAGE(PG8_SB(1, 0), cB + kstep, voffB); PG8_STAGE(PG8_SA(1, 0), cA + kstep, voffA); PG8_STAGE(PG8_SB(1, 1), cB + hstep + kstep, voffB);
        PG8_WAIT_V(6); PG8_BAR;
    } else {
        PG8_STAGE(PG8_SB(0, 0), cB, voffB); PG8_STAGE(PG8_SA(0, 0), cA, voffA); PG8_STAGE(PG8_SB(0, 1), cB + hstep, voffB); PG8_STAGE(PG8_SA(0, 1), cA + hstep, voffA);
        if (wr == 1) PG8_BAR;
        PG8_WAIT_V(4); PG8_BAR;
        PG8_STAGE(PG8_SB(1, 0), cB + kstep, voffB); PG8_STAGE(PG8_SA(1, 0), cA + kstep, voffA); PG8_STAGE(PG8_SB(1, 1), cB + hstep + kstep, voffB);
        PG8_WAIT_V(6); PG8_BAR;
    }
    for (;;) {
        const bool has_next = S.next(ui + 1, nxt);
        const char* nA = has_next ? (const char*)g.A + (size_t)nxt.pm * tstepA : cA; const char* nB = has_next ? (const char*)g.Bt + (size_t)nxt.pn * tstep : cB;
        for (int t = 0; t < nt; t += 2) {
            const bool last = (t == nt - 2);
            const char* a1 = cA + (size_t)(t + 1) * kstep;
            const char* a2 = last ? nA : cA + (size_t)(t + 2) * kstep; const char* b2 = last ? nB : cB + (size_t)(t + 2) * kstep;
            const char* a3 = a2 + kstep; const char* b3 = b2 + kstep;
            if (last && has_next) S.a_ready(nxt);
            if constexpr (SP2) {
            PG8_LDB(B0, 0, 0); PG8_LDB(B1, 0, 1); PG8_SCHED; PG8_LDA(At, 0, 0); PG8_STAGE(PG8_SA(1, 1), a1 + hstep, voffA);
            PG8_WAIT_V(8); PG8_WAIT_L(0); PG8_BAR; PG8_MMA(0, 0, At, B0); PG8_MMA(0, 1, At, B1); PG8_BAR; PG8_SCHED;
            PG8_LDA(At, 0, 1); PG8_STAGE(PG8_SB(0, 0), b2, voffB); PG8_STAGE(PG8_SB(0, 1), b2 + hstep, voffB); PG8_STAGE(PG8_SA(0, 0), a2, voffA);
            PG8_WAIT_V(8); PG8_WAIT_L(0); PG8_BAR; PG8_MMA(1, 0, At, B0); PG8_MMA(1, 1, At, B1); PG8_BAR; PG8_SCHED;
            PG8_LDB(B0, 1, 0); PG8_LDB(B1, 1, 1); PG8_SCHED; PG8_LDA(At, 1, 0); PG8_STAGE(PG8_SA(0, 1), a2 + hstep, voffA);
            PG8_WAIT_V(8); PG8_WAIT_L(0); PG8_BAR; PG8_MMA(0, 0, At, B0); PG8_MMA(0, 1, At, B1); PG8_BAR; PG8_SCHED;
            PG8_LDA(At, 1, 1); PG8_STAGE(PG8_SB(1, 0), b3, voffB); PG8_STAGE(PG8_SB(1, 1), b3 + hstep, voffB); PG8_STAGE(PG8_SA(1, 0), a3, voffA);
            PG8_WAIT_V(8); PG8_WAIT_L(0); PG8_BAR; PG8_MMA(1, 0, At, B0); PG8_MMA(1, 1, At, B1); PG8_BAR; PG8_SCHED;
            } else {
            PG8_LDB(B0, 0, 0); PG8_SCHED; PG8_LDA(At, 0, 0); PG8_STAGE(PG8_SA(1, 1), a1 + hstep, voffA);
            PG8_WAIT_L(8); PG8_BAR; PG8_WAIT_L(0); PG8_MMA(0, 0, At, B0); PG8_BAR; PG8_SCHED;
            PG8_LDB(B1, 0, 1); PG8_STAGE(PG8_SB(0, 0), b2, voffB);
            PG8_BAR; PG8_WAIT_L(0); PG8_MMA(0, 1, At, B1); PG8_BAR;
            PG8_LDA(At, 0, 1); PG8_STAGE(PG8_SA(0, 0), a2, voffA);
            PG8_BAR; PG8_WAIT_L(0); PG8_MMA(1, 0, At, B0); PG8_BAR; PG8_SCHED;
            PG8_STAGE(PG8_SB(0, 1), b2 + hstep, voffB);
            PG8_WAIT_V(6); PG8_BAR; PG8_MMA(1, 1, At, B1); PG8_BAR;
            PG8_LDB(B0, 1, 0); PG8_SCHED; PG8_LDA(At, 1, 0); PG8_STAGE(PG8_SA(0, 1), a2 + hstep, voffA);
            PG8_WAIT_L(8); PG8_BAR; PG8_WAIT_L(0); PG8_MMA(0, 0, At, B0); PG8_BAR; PG8_SCHED;
            PG8_LDB(B1, 1, 1); PG8_STAGE(PG8_SB(1, 0), b3, voffB);
            PG8_BAR; PG8_WAIT_L(0); PG8_MMA(0, 1, At, B1); PG8_BAR;
            PG8_LDA(At, 1, 1); PG8_STAGE(PG8_SA(1, 0), a3, voffA);
            PG8_BAR; PG8_WAIT_L(0); PG8_MMA(1, 0, At, B0); PG8_BAR; PG8_SCHED;
            PG8_STAGE(PG8_SB(1, 1), b3 + hstep, voffB);
            PG8_WAIT_V(6); PG8_BAR; PG8_MMA(1, 1, At, B1); PG8_BAR;
            }
        }
        if constexpr (ALIGN_EPI) { if (wr == 0) PG8_BAR; }
        if constexpr (!Epi::AFTER_DRAIN) { E(acc, cur, wr, wc, fr, fq); S.done(cur); }
        if (!has_next) break;
#pragma unroll
        for (int a = 0; a < 2; ++a)
#pragma unroll
            for (int b = 0; b < 2; ++b)
#pragma unroll
                for (int m = 0; m < 4; ++m)
#pragma unroll
                    for (int n = 0; n < 2; ++n) acc[a][b][m][n] = (f32x4){0.f, 0.f, 0.f, 0.f};
        cur = nxt; cA = nA; cB = nB; ++ui;
        if constexpr (ALIGN_EPI) { if (wr == 1) PG8_BAR; }
    }
    PG8_WAIT_V(0);
    if constexpr (!ALIGN_EPI) { if (wr == 0) PG8_BAR; }
    PG8_BAR;
    if constexpr (Epi::AFTER_DRAIN) { E.fused(acc, cur, wr, wc, fr, fq, lds, wid, lane); S.done(cur); }
#undef PG8_SA
#undef PG8_SB
#undef PG8_STAGE
#undef PG8_LDA
#undef PG8_LDB
#undef PG8_MMA
#undef PG8_WAIT_V
#undef PG8_WAIT_L
#undef PG8_BAR
#undef PG8_SCHED
}
}

constexpr int NB = 4, SEQ = 4096, D = 1024, M = NB * SEQ;
constexpr int NH = 8, HD = 64, ATT_W = 512, KV_W = 128, CONV_W = 512, DFF = 2816, NPROJ = 4352, NPA = 2304, NGATE = 2048;
constexpr int C_Q = 0, C_K = 512, C_V = 640, C_CB = 768, C_CC = 1280, C_CX = 1792;
constexpr float LN_EPS = 1e-5f;
constexpr float ALPHA = 1.189207115002721f;
constexpr int NWAVES = 8;

constexpr size_t MiB = 1u << 20;
constexpr size_t WS_CTL = 0, CTL_ZERO_BYTES = 1 * MiB;
constexpr size_t WS_WIN = 2 * MiB;
constexpr size_t WS_WA = 11 * MiB;
constexpr size_t WS_WC = 12 * MiB;
constexpr size_t WS_WO = 13 * MiB;
constexpr size_t WS_WUP = 15 * MiB;
constexpr size_t WS_WDN = 26 * MiB;
constexpr size_t WS_H0B = 32 * MiB;
constexpr size_t WS_PA = 64 * MiB;
constexpr size_t WS_G = 136 * MiB;
constexpr size_t WS_ATT = 200 * MiB;
constexpr size_t WS_CONV = 216 * MiB;
constexpr size_t WS_T1 = 32 * MiB;
constexpr size_t WS_MERGED = 96 * MiB;
constexpr size_t WS_MIX = 128 * MiB;
constexpr size_t WS_H1B = 193 * MiB;
constexpr size_t WS_ACT = 32 * MiB;
constexpr size_t WS_FFN = 128 * MiB;
constexpr size_t WS_END = 256 * MiB;
constexpr int CW_BAR = 4096;

constexpr int RING_OFF = 0, RING_BYTES = 131072;
constexpr int LDSCTL_OFF = RING_BYTES, MISC_OFF = LDSCTL_OFF + 320;
constexpr int HALO_OFF = RING_BYTES + 1024;
constexpr int LDS_BYTES = 147456;

#define GAS __attribute__((address_space(1)))
#define LAS __attribute__((address_space(3)))
typedef unsigned short bf16;
typedef unsigned v4u __attribute__((ext_vector_type(4)));
typedef unsigned v2u __attribute__((ext_vector_type(2)));
typedef float f32x4 __attribute__((ext_vector_type(4)));
typedef float f32x16 __attribute__((ext_vector_type(16)));
typedef short bf16x8 __attribute__((ext_vector_type(8)));
typedef short s16x4 __attribute__((ext_vector_type(4)));
typedef GAS unsigned gu32;
typedef GAS unsigned long long gu64;
#define RLX_AGENT __ATOMIC_RELAXED, __HIP_MEMORY_SCOPE_AGENT
#define LDS_WAIT() asm volatile("s_waitcnt lgkmcnt(0)" ::: "memory")
#define VM_WAIT() asm volatile("s_waitcnt vmcnt(0)" ::: "memory")
__device__ __forceinline__ unsigned f2bf(float f) { unsigned u = __builtin_bit_cast(unsigned, f); return (u + 0x7fffu + ((u >> 16) & 1u)) >> 16; }
__device__ __forceinline__ unsigned pk2(float lo, float hi) { return f2bf(lo) | (f2bf(hi) << 16); }
__device__ __forceinline__ float bflo(unsigned w) { return __uint_as_float(w << 16); }
__device__ __forceinline__ float bfhi(unsigned w) { return __uint_as_float(w & 0xffff0000u); }

#define XB_TMO      128
#define XB_XCNT(j)  (256  + 64 * (j))
#define XB_XSUB(j)  (1280 + 64 * (j))
#define XB_XGEN(j)  (2304 + 64 * (j))
#define XB_TOP      3328
#define XB_TOPGEN   3392
#define XCD_BAR_WORDS 3456
#define XB_SPIN_CAP (1u << 18)

__device__ __forceinline__ unsigned xb_ld(unsigned* p)              { return __hip_atomic_load(p, __ATOMIC_RELAXED, __HIP_MEMORY_SCOPE_AGENT); }
__device__ __forceinline__ unsigned xb_add(unsigned* p, unsigned v) { return __hip_atomic_fetch_add(p, v, __ATOMIC_RELAXED, __HIP_MEMORY_SCOPE_AGENT); }
__device__ __forceinline__ unsigned xb_xcc_id() { return (unsigned)__builtin_amdgcn_s_getreg((3 << 11) | 20) & 0xFu; }
#define XB_SPIN(cond, bar) do { unsigned _sp = 0; while (cond) { __builtin_amdgcn_s_sleep(1); \
    if ((++_sp & 255u) == 0u) { if (xb_ld(&(bar)[XB_TMO])) break; if (_sp > XB_SPIN_CAP) { atomicAdd(&(bar)[XB_TMO], 1u); break; } } } } while (0)

struct XcdBarrier {
    unsigned* bar; unsigned x;
    volatile LAS unsigned* st;
};

__device__ __forceinline__ XcdBarrier xcd_barrier_post(unsigned* bar, volatile LAS unsigned* st) {
    XcdBarrier b; b.bar = bar; b.x = xb_xcc_id(); b.st = st;
    if (threadIdx.x == 0) (void)xb_add(&bar[XB_XCNT(b.x)], 1u);
    return b;
}
__device__ __forceinline__ void xcd_barrier_complete(unsigned* bar, unsigned x, unsigned& nloc, unsigned& nx) {
    const unsigned G = gridDim.x * gridDim.y * gridDim.z;
    unsigned sum, cnt, mine, sp = 0u;
    for (;;) {
        sum = 0u; cnt = 0u; mine = 0u;
#pragma unroll
        for (unsigned j = 0; j < 16; ++j) { const unsigned c = xb_ld(&bar[XB_XCNT(j)]); sum += c; cnt += (c > 0u) ? 1u : 0u; mine = (j == x) ? c : mine; }
        if (sum == G) break;
        __builtin_amdgcn_s_sleep(1);
        if ((++sp & 255u) == 0u) { if (xb_ld(&bar[XB_TMO])) break; if (sp > XB_SPIN_CAP) { atomicAdd(&bar[XB_TMO], 1u); break; } }
    }
    nloc = mine > 0u ? mine : 1u; nx = cnt > 0u ? cnt : 1u;
}

__device__ __forceinline__ void xcd_barrier(const XcdBarrier& b) {
    asm volatile("s_waitcnt vmcnt(0)" ::: "memory");
    __syncthreads();
    if (threadIdx.x == 0) {
        unsigned* bar = b.bar;
        __builtin_amdgcn_s_waitcnt(0);
        unsigned nloc = b.st[0], nx = b.st[1];
        if (nloc == 0u) { xcd_barrier_complete(bar, b.x, nloc, nx); b.st[0] = nloc; b.st[1] = nx; }
        const unsigned old = xb_add(&bar[XB_XSUB(b.x)], 1u);
        const unsigned gen = old / nloc;
        if (old + 1u == (gen + 1u) * nloc) {
            __builtin_amdgcn_fence(__ATOMIC_RELEASE, "agent");
            asm volatile("s_waitcnt vmcnt(0)" ::: "memory");
            const unsigned og = xb_add(&bar[XB_TOP], 1u);
            const unsigned tg = og / nx;
            if (og + 1u == (tg + 1u) * nx) xb_add(&bar[XB_TOPGEN], 1u);
            else XB_SPIN(xb_ld(&bar[XB_TOPGEN]) == tg, bar);
            __builtin_amdgcn_fence(__ATOMIC_ACQUIRE, "agent");
            xb_add(&bar[XB_XGEN(b.x)], 1u);
            asm volatile("s_waitcnt vmcnt(0)" ::: "memory");
        } else {
            XB_SPIN(xb_ld(&bar[XB_XGEN(b.x)]) == gen, bar);
            __builtin_amdgcn_fence(__ATOMIC_ACQUIRE, "agent");
            asm volatile("s_waitcnt vmcnt(0)" ::: "memory");
        }
    }
    __syncthreads();
}

__device__ __forceinline__ float wave_sum(float v) {
#pragma unroll
    for (int o = 1; o < 64; o <<= 1) v += __shfl_xor(v, o);
    return v;
}
template <bool UPMAP = false> __device__ __forceinline__ void p0_transpose_item(const float* W, int K, int N, bf16* WT, LAS float* scr, int item, int lane) {
    const int nblk = N / 32, kb = item / nblk, nb = item % nblk, k0 = 64 * kb, n0 = 32 * nb;
    const int d0 = UPMAP ? (n0 < DFF ? 256 * (n0 / 128) + (n0 % 128) : 256 * ((n0 - DFF) / 128) + 128 + ((n0 - DFF) % 128)) : n0;
#pragma unroll 8
    for (int i = 0; i < 32; ++i) { const int kk = 2 * i + (lane >> 5); scr[kk * 33 + (lane & 31)] = W[(size_t)(k0 + kk) * N + n0 + (lane & 31)]; }
    LDS_WAIT(); asm volatile("" ::: "memory");
    const int c = lane & 7;
#pragma unroll
    for (int j = 0; j < 4; ++j) { const int n = (lane >> 3) + 8 * j; const LAS float* s = scr + (8 * c) * 33 + n;
        v4u o; o.x = pk2(s[0 * 33], s[1 * 33]); o.y = pk2(s[2 * 33], s[3 * 33]); o.z = pk2(s[4 * 33], s[5 * 33]); o.w = pk2(s[6 * 33], s[7 * 33]);
        *(GAS v4u*)(WT + (size_t)(d0 + n) * K + k0 + 8 * c) = o; }
    LDS_WAIT(); asm volatile("" ::: "memory");
}
__device__ __forceinline__ void row_stats(f32x4 (&v)[4], float& mean, float& rstd) {
    float s = 0.f;
#pragma unroll
    for (int j = 0; j < 4; ++j) s += (v[j].x + v[j].y) + (v[j].z + v[j].w);
    mean = wave_sum(s) * (1.f / D); float s2 = 0.f;
#pragma unroll
    for (int j = 0; j < 4; ++j) { v[j] = v[j] - mean; s2 += (v[j].x * v[j].x + v[j].y * v[j].y) + (v[j].z * v[j].z + v[j].w * v[j].w); }
    rstd = 1.f / sqrtf(wave_sum(s2) * (1.f / D) + LN_EPS);
}
__device__ __forceinline__ void ln0_row(const float* xrow, const float* g, const float* b, f32x4 (&v)[4], int lane) {
    const GAS f32x4* xr = (const GAS f32x4*)xrow + lane;
#pragma unroll
    for (int j = 0; j < 4; ++j) v[j] = xr[64 * j];
    float mean, rstd; row_stats(v, mean, rstd);
#pragma unroll
    for (int j = 0; j < 4; ++j) { const f32x4 gv = ((const GAS f32x4*)g)[lane + 64 * j], bv = ((const GAS f32x4*)b)[lane + 64 * j]; v[j] = v[j] * rstd * gv + bv; }
}
__device__ __forceinline__ void store_row_bf16(bf16* orow, const f32x4 (&v)[4], int lane) {
    GAS unsigned long long* o8 = (GAS unsigned long long*)orow + lane;
#pragma unroll
    for (int j = 0; j < 4; ++j) o8[64 * j] = (unsigned long long)pk2(v[j].x, v[j].y) | ((unsigned long long)pk2(v[j].z, v[j].w) << 32);
}

namespace att {
constexpr int VROWB = 144;
constexpr int WAVE_LDS = 32 * VROWB;
constexpr int TBL_OFF = 8 * WAVE_LDS;
constexpr int TBL_STRIDE = 264;
constexpr float LOG2E = 1.4426950408889634f;
__device__ __forceinline__ int crow(int r, int hi) { return (r & 3) + 8 * (r >> 2) + 4 * hi; }
__device__ __forceinline__ s16x4 vtr(const LAS unsigned char* p) {
    typedef short v4i16_t __attribute__((ext_vector_type(4)));
    return __builtin_bit_cast(s16x4, __builtin_amdgcn_ds_read_tr16_b64_v4i16((LAS v4i16_t*)p));
}
__device__ __forceinline__ void build_table(LAS float* tbl, const float* rel_bias, int tid) {
    for (int idx = tid; idx < NH * 257; idx += NWAVES * 64) {
        const int h = idx / 257, rr = idx % 257, rel = rr - 128, n = rel < 0 ? -rel : rel;
        int bucket;
        if (n < 8) bucket = n; else { int lg = 2 + (31 - __builtin_clz((unsigned)(n * n))); bucket = lg < 15 ? lg : 15; }
        if (rel > 0) bucket += 16;
        tbl[h * TBL_STRIDE + rr] = rel_bias[bucket * NH + h];
    }
}
__device__ __forceinline__ void attn_wave(int b, int q0, int h, const bf16* PA, bf16* O, const LAS float* tbl, LAS unsigned char* vlds, float sinkv, int lane) {
    const int r32 = lane & 31, hi = lane >> 5, kvh = h >> 2;
    const size_t qrow = (size_t)b * SEQ + q0 + r32;
    bf16x8 qf[4];
#pragma unroll
    for (int d0 = 0; d0 < 4; ++d0) qf[d0] = *(const GAS bf16x8*)(PA + qrow * NPA + C_Q + h * HD + 16 * d0 + 8 * hi);
    float m = sinkv, l = hi == 0 ? 1.f : 0.f;
    f32x16 o0, o1;
#pragma unroll
    for (int r = 0; r < 16; ++r) { o0[r] = 0.f; o1[r] = 0.f; }
    const int qpos = q0 + r32;
    const LAS float* tb = tbl + h * TBL_STRIDE + 128;
    const int tro = (4 * hi + ((lane & 15) >> 2)) * VROWB + (16 * ((lane >> 4) & 1) + 4 * (lane & 3)) * 2;
    for (int t = 0; t < 9; ++t) {
        const int key0 = q0 - 128 + 32 * t;
        if (key0 < 0 || key0 >= SEQ) continue;
        const size_t krow = (size_t)b * SEQ + key0 + r32;
        bf16x8 kf[4];
#pragma unroll
        for (int d0 = 0; d0 < 4; ++d0) kf[d0] = *(const GAS bf16x8*)(PA + krow * NPA + C_K + kvh * HD + 16 * d0 + 8 * hi);
        v4u vv[4];
#pragma unroll
        for (int i = 0; i < 4; ++i) { const int vr = 8 * i + (lane >> 3), ch = lane & 7;
            vv[i] = *(const GAS v4u*)(PA + ((size_t)b * SEQ + key0 + vr) * NPA + C_V + kvh * HD + ch * 8); }
        f32x16 p;
#pragma unroll
        for (int r = 0; r < 16; ++r) p[r] = 0.f;
#pragma unroll
        for (int d0 = 0; d0 < 4; ++d0) p = __builtin_amdgcn_mfma_f32_32x32x16_bf16(kf[d0], qf[d0], p, 0, 0, 0);
        asm volatile("" ::: "memory");
#pragma unroll
        for (int i = 0; i < 4; ++i) { const int vr = 8 * i + (lane >> 3), ch = lane & 7; *(LAS v4u*)(vlds + vr * VROWB + ch * 16) = vv[i]; }
        asm volatile("" ::: "memory");
        float mx = -INFINITY;
#pragma unroll
        for (int r = 0; r < 16; ++r) {
            const int rel = key0 + crow(r, hi) - qpos; const bool valid = (rel >= -128) && (rel <= 128);
            const int rc = rel < -128 ? -128 : (rel > 128 ? 128 : rel);
            const float s = valid ? p[r] * 0.125f + tb[rc] : -INFINITY;
            p[r] = s; mx = fmaxf(mx, s);
        }
        mx = fmaxf(mx, __shfl_xor(mx, 32));
        const float mnew = fmaxf(m, mx), alpha = __builtin_amdgcn_exp2f((m - mnew) * LOG2E); m = mnew;
        float ps = 0.f;
#pragma unroll
        for (int r = 0; r < 16; ++r) { p[r] = __builtin_amdgcn_exp2f((p[r] - mnew) * LOG2E); ps += p[r]; }
        l = l * alpha + ps;
#pragma unroll
        for (int r = 0; r < 16; ++r) { o0[r] *= alpha; o1[r] *= alpha; }
        v4u pw0, pw1;
        pw0.x = pk2(p[0], p[1]); pw0.y = pk2(p[2], p[3]); pw0.z = pk2(p[4], p[5]); pw0.w = pk2(p[6], p[7]);
        pw1.x = pk2(p[8], p[9]); pw1.y = pk2(p[10], p[11]); pw1.z = pk2(p[12], p[13]); pw1.w = pk2(p[14], p[15]);
        const bf16x8 pb0 = __builtin_bit_cast(bf16x8, pw0), pb1 = __builtin_bit_cast(bf16x8, pw1);
        LDS_WAIT();
#pragma unroll
        for (int s = 0; s < 2; ++s) {
#pragma unroll
            for (int db = 0; db < 2; ++db) {
                const LAS unsigned char* pa = vlds + tro + (16 * s) * VROWB + db * 64;
                const s16x4 lo = vtr(pa), hi4 = vtr(pa + 8 * VROWB);
                const bf16x8 vf = (bf16x8){lo[0], lo[1], lo[2], lo[3], hi4[0], hi4[1], hi4[2], hi4[3]};
                if (db == 0) o0 = __builtin_amdgcn_mfma_f32_32x32x16_bf16(vf, s == 0 ? pb0 : pb1, o0, 0, 0, 0);
                else         o1 = __builtin_amdgcn_mfma_f32_32x32x16_bf16(vf, s == 0 ? pb0 : pb1, o1, 0, 0, 0);
            }
        }
        asm volatile("" ::: "memory");
    }
    const float lt = l + __shfl_xor(l, 32), inv = 1.f / lt;
    bf16* orow = O + qrow * ATT_W + h * HD;
#pragma unroll
    for (int rr = 0; rr < 4; ++rr) {
        v2u w0, w1;
        w0.x = pk2(o0[4 * rr] * inv, o0[4 * rr + 1] * inv); w0.y = pk2(o0[4 * rr + 2] * inv, o0[4 * rr + 3] * inv);
        w1.x = pk2(o1[4 * rr] * inv, o1[4 * rr + 1] * inv); w1.y = pk2(o1[4 * rr + 2] * inv, o1[4 * rr + 3] * inv);
        *(GAS v2u*)(orow + 8 * rr + 4 * hi) = w0;
        *(GAS v2u*)(orow + 32 + 8 * rr + 4 * hi) = w1;
    }
}
}


#ifndef ATT_NAIVE
#define ATT_NAIVE 0
#endif
#if ATT_NAIVE
__device__ __forceinline__ void attn_naive(int row, int h, const bf16* PA, bf16* O, const float* rel_bias, const float* sink) {
    const int b = row / SEQ, t = row % SEQ, kvh = h >> 2;
    float q[HD], o[HD];
    const bf16* qp = PA + (size_t)row * NPA + C_Q + h * HD;
#pragma unroll
    for (int d = 0; d < HD; ++d) { q[d] = __uint_as_float((unsigned)qp[d] << 16); o[d] = 0.f; }
    float m = sink[h], l = 1.f;
    for (int rel = -128; rel <= 128; ++rel) {
        const int kt = t + rel; if (kt < 0 || kt >= SEQ) continue;
        const bf16* kp = PA + ((size_t)b * SEQ + kt) * NPA + C_K + kvh * HD; const bf16* vp = kp + (C_V - C_K);
        float s = 0.f;
#pragma unroll
        for (int d = 0; d < HD; ++d) s += q[d] * __uint_as_float((unsigned)kp[d] << 16);
        const int n = rel < 0 ? -rel : rel; int bucket;
        if (n < 8) bucket = n; else { int c = 8; for (int j = 1; j <= 8; ++j) if (n * n >= (64 << j)) ++c; bucket = c < 15 ? c : 15; }
        if (rel > 0) bucket += 16;
        s = s * 0.125f + rel_bias[bucket * NH + h];
        const float mn = fmaxf(m, s), a = __expf(m - mn), p = __expf(s - mn); m = mn; l = l * a + p;
#pragma unroll
        for (int d = 0; d < HD; ++d) o[d] = o[d] * a + p * __uint_as_float((unsigned)vp[d] << 16);
    }
    const float inv = 1.f / l; bf16* op = O + (size_t)row * ATT_W + h * HD;
#pragma unroll
    for (int d = 0; d < HD; ++d) op[d] = (bf16)f2bf(o[d] * inv);
}
#endif

#ifndef GEMM_CHECK
#define GEMM_CHECK 0
#endif
#ifndef CHK_THR
#define CHK_THR 1e-7f
#endif
#if GEMM_CHECK
constexpr int CW_CHK = 2048;
__device__ __forceinline__ float bfv(const bf16* p) { return __uint_as_float((unsigned)(*p) << 16); }
__device__ __forceinline__ float dot_bf16(const bf16* a, const bf16* b, int K) {
    float s = 0.f;
    for (int k = 0; k < K; k += 8) { const v4u x = *(const GAS v4u*)(a + k), y = *(const GAS v4u*)(b + k);
#pragma unroll
        for (int e = 0; e < 4; ++e) { s += bflo(x[e]) * bflo(y[e]); s += bfhi(x[e]) * bfhi(y[e]); } }
    return s;
}
__device__ __forceinline__ void chk_add(gu32* ctl, int k, float d2, float r2) {
    d2 = wave_sum(d2); r2 = wave_sum(r2);
    if ((threadIdx.x & 63) == 0) { atomicAdd((float*)(ctl + CW_CHK + 64 * (2 * k)), d2); atomicAdd((float*)(ctl + CW_CHK + 64 * (2 * k + 1)), r2); }
}
__device__ __forceinline__ void chk_rc(unsigned g, unsigned s, int rows, int cols, int& row, int& col) {
    unsigned h = (g * 2654435761u) ^ (s * 0x9E3779B9u + 0x7F4A7C15u); h ^= h >> 15; h *= 2246822519u; h ^= h >> 13;
    row = (int)(h % (unsigned)rows); h = h * 3266489917u + 374761393u; h ^= h >> 16; col = (int)(h % (unsigned)cols);
}
#define CHK_LOOP(k, rows, cols, REFEXPR, VALEXPR) do { float d2_ = 0.f, r2_ = 0.f; \
    for (unsigned s_ = 0; s_ < 4; ++s_) { int row, col; chk_rc((unsigned)(vcu * 512 + threadIdx.x), s_ + 16u * (k), rows, cols, row, col); \
        const float ref_ = (REFEXPR), val_ = (VALEXPR); d2_ += (val_ - ref_) * (val_ - ref_); r2_ += ref_ * ref_; } \
    chk_add(ctl, k, d2_, r2_); } while (0)
__device__ __forceinline__ float rbf(float f) { return __uint_as_float(f2bf(f) << 16); }
__device__ __forceinline__ float rbf0(float f) { return f; }
#endif
struct Args { const float* in[20]; float* out; unsigned char* ws; };
__global__ void __launch_bounds__(NWAVES * 64, 2) hyb_fwd(Args args) {
    extern __shared__ __attribute__((aligned(16))) unsigned char lds_raw[];
    LAS unsigned char* lds = (LAS unsigned char*)lds_raw;
    volatile LAS unsigned* MISC = (volatile LAS unsigned*)(lds + MISC_OFF);
    const int tid0 = threadIdx.x, wave = __builtin_amdgcn_readfirstlane(tid0 >> 6);
#define PHASE_IDS int tid = threadIdx.x; asm volatile("" : "+v"(tid)); const int lane = tid & 63; (void)lane
    const int G = gridDim.x, bx = blockIdx.x, vcu = (G % 8 == 0) ? (bx % 8) * (G / 8) + bx / 8 : bx;
    unsigned char* ws = args.ws;
    gu32* ctl = (gu32*)(ws + WS_CTL);
    const float* x = args.in[0]; float* out = args.out;
    bf16* WIN = (bf16*)(ws + WS_WIN); bf16* WA = (bf16*)(ws + WS_WA); bf16* WC = (bf16*)(ws + WS_WC); bf16* WO = (bf16*)(ws + WS_WO);
    bf16* WUP = (bf16*)(ws + WS_WUP); bf16* WDN = (bf16*)(ws + WS_WDN);
    bf16* H0B = (bf16*)(ws + WS_H0B); bf16* PA = (bf16*)(ws + WS_PA); bf16* GT = (bf16*)(ws + WS_G);
    bf16* ATT = (bf16*)(ws + WS_ATT); bf16* CONV = (bf16*)(ws + WS_CONV); float* T1 = (float*)(ws + WS_T1);
    bf16* MERGED = (bf16*)(ws + WS_MERGED); float* MIX = (float*)(ws + WS_MIX); bf16* H1B = (bf16*)(ws + WS_H1B);
    bf16* ACT = (bf16*)(ws + WS_ACT); float* FFN = (float*)(ws + WS_FFN);

    for (int u = tid0; u < (LDS_BYTES - LDSCTL_OFF) / 4; u += NWAVES * 64) ((LAS unsigned*)(lds + LDSCTL_OFF))[u] = 0u;
    __syncthreads();
    XcdBarrier bar = xcd_barrier_post((unsigned*)(ctl + CW_BAR), MISC + 8);
#define GRID_BAR() xcd_barrier(bar)
    const int gw = vcu * NWAVES + wave, NGW = G * NWAVES;

    {
        PHASE_IDS;
        LAS float* scr = (LAS float*)(lds + RING_OFF + wave * 16384);
        constexpr int I_IN = (D / 64) * (NPROJ / 32), I_A = (ATT_W / 64) * (D / 32), I_C = (CONV_W / 64) * (D / 32), I_O = (D / 64) * (D / 32),
                      I_UP = (D / 64) * (2 * DFF / 32), I_DN = (DFF / 64) * (D / 32);
        constexpr int NITEMS = I_IN + I_A + I_C + I_O + I_UP + I_DN;
        for (int it = gw; it < NITEMS; it += NGW) {
            int r = it;
            if (r < I_IN) { p0_transpose_item(args.in[3], D, NPROJ, WIN, scr, r, lane); continue; } r -= I_IN;
            if (r < I_A) { p0_transpose_item(args.in[9], ATT_W, D, WA, scr, r, lane); continue; } r -= I_A;
            if (r < I_C) { p0_transpose_item(args.in[10], CONV_W, D, WC, scr, r, lane); continue; } r -= I_C;
            if (r < I_O) { p0_transpose_item(args.in[11], D, D, WO, scr, r, lane); continue; } r -= I_O;
            if (r < I_UP) { p0_transpose_item<true>(args.in[14], D, 2 * DFF, WUP, scr, r, lane); continue; } r -= I_UP;
            p0_transpose_item(args.in[17], DFF, D, WDN, scr, r, lane);
        }
        for (int m = gw; m < M; m += NGW) { f32x4 v[4]; ln0_row(x + (size_t)m * D, args.in[1], args.in[2], v, lane); store_row_bf16(H0B + (size_t)m * D, v, lane); }
    }
    GRID_BAR();

    {
        pg8::Gemm g{H0B, WIN, M, NPROJ, D}; pg8::StaticOrder S; S.init(M, NPROJ, G, bx);
        pg8::EpiProj E{PA, GT, args.in[4]};
        pg8::gemm_phase<pg8::EpiProj, pg8::StaticOrder, true, true>(lds + RING_OFF, g, S, E);
    }
    GRID_BAR();
#if GEMM_CHECK
    CHK_LOOP(0, M, NPA, rbf(dot_bf16(H0B + (size_t)row * D, WIN + (size_t)col * D, D)), bfv(PA + (size_t)row * NPA + col));
    CHK_LOOP(1, M, NGATE, rbf(pg8::sigmoid_f(dot_bf16(H0B + (size_t)row * D, WIN + (size_t)(NPA + col) * D, D) + args.in[4][col])), bfv(GT + (size_t)row * NGATE + col));
#endif

    {
        PHASE_IDS;
        LAS float* tbl = (LAS float*)(lds + att::TBL_OFF);
        att::build_table(tbl, args.in[6], tid);
        __syncthreads();
        const float sinkv = args.in[5][wave];
#if ATT_NAIVE
        (void)sinkv;
        for (int it = vcu * (NWAVES * 64) + tid; it < M * NH; it += G * NWAVES * 64) attn_naive(it >> 3, it & 7, PA, ATT, args.in[6], args.in[5]);
#else
        for (int u = vcu; u < NB * (SEQ / 32); u += G) {
            const int b = u / (SEQ / 32), q0 = (u % (SEQ / 32)) * 32;
            att::attn_wave(b, q0, wave, PA, ATT, tbl, lds + wave * att::WAVE_LDS, sinkv, lane);
        }
#endif
        const float* cw = args.in[7]; const float* cbias = args.in[8];
        for (int it = vcu * (NWAVES * 64) + tid; it < M * 64; it += G * NWAVES * 64) {
            const int row = it >> 6, ch = it & 63, t = row & (SEQ - 1);
            const bf16* base = PA + (size_t)row * NPA + 8 * ch;
            const v4u z = (v4u){0u, 0u, 0u, 0u};
            const v4u cb = *(const GAS v4u*)(base + C_CB), cc1 = *(const GAS v4u*)(base + C_CC), cx1 = *(const GAS v4u*)(base + C_CX);
            const v4u cc0 = t > 0 ? *(const GAS v4u*)(base - NPA + C_CC) : z, cx0 = t > 0 ? *(const GAS v4u*)(base - NPA + C_CX) : z;
            const v4u cc2 = t < SEQ - 1 ? *(const GAS v4u*)(base + NPA + C_CC) : z, cx2 = t < SEQ - 1 ? *(const GAS v4u*)(base + NPA + C_CX) : z;
            float w0[8], w1[8], w2[8], bb[8];
#pragma unroll
            for (int e = 0; e < 8; ++e) { w0[e] = cw[8 * ch + e]; w1[e] = cw[CONV_W + 8 * ch + e]; w2[e] = cw[2 * CONV_W + 8 * ch + e]; bb[e] = cbias[8 * ch + e]; }
            v4u o;
#pragma unroll
            for (int k = 0; k < 4; ++k) {
                const float p0l = bflo(cc0[k]) * bflo(cx0[k]), p0h = bfhi(cc0[k]) * bfhi(cx0[k]);
                const float p1l = bflo(cc1[k]) * bflo(cx1[k]), p1h = bfhi(cc1[k]) * bfhi(cx1[k]);
                const float p2l = bflo(cc2[k]) * bflo(cx2[k]), p2h = bfhi(cc2[k]) * bfhi(cx2[k]);
                const float yl = bflo(cb[k]) * (w0[2 * k] * p0l + w1[2 * k] * p1l + w2[2 * k] * p2l + bb[2 * k]);
                const float yh = bfhi(cb[k]) * (w0[2 * k + 1] * p0h + w1[2 * k + 1] * p1h + w2[2 * k + 1] * p2h + bb[2 * k + 1]);
                o[k] = pk2(yl, yh);
            }
            *(GAS v4u*)(CONV + (size_t)row * CONV_W + 8 * ch) = o;
        }
    }
    GRID_BAR();

    {
        pg8::StaticOrder S; S.init(M, D, G, bx);
        { pg8::Gemm g{ATT, WA, M, D, ATT_W}; pg8::EpiGateF32 E{T1, GT, 0};
          pg8::gemm_phase<pg8::EpiGateF32, pg8::StaticOrder, true, true>(lds + RING_OFF, g, S, E); }
        VM_WAIT(); __syncthreads();
        { pg8::Gemm g{CONV, WC, M, D, CONV_W}; pg8::EpiMerge E{T1, GT, 1024, MERGED};
          pg8::gemm_phase<pg8::EpiMerge, pg8::StaticOrder, true, true>(lds + RING_OFF, g, S, E); }
    }
    GRID_BAR();
#if GEMM_CHECK
    CHK_LOOP(2, M, D, rbf(bfv(GT + (size_t)row * NGATE + col) * dot_bf16(ATT + (size_t)row * ATT_W, WA + (size_t)col * ATT_W, ATT_W) + bfv(GT + (size_t)row * NGATE + 1024 + col) * dot_bf16(CONV + (size_t)row * CONV_W, WC + (size_t)col * CONV_W, CONV_W)), bfv(MERGED + (size_t)row * D + col));
#endif

    {
        pg8::Gemm g{MERGED, WO, M, D, D}; pg8::StaticOrder S; S.init(M, D, G, bx);
        pg8::EpiF32 E{MIX, D};
        pg8::gemm_phase<pg8::EpiF32, pg8::StaticOrder, true, true>(lds + RING_OFF, g, S, E);
    }
    GRID_BAR();
#if GEMM_CHECK
    CHK_LOOP(3, M, D, dot_bf16(MERGED + (size_t)row * D, WO + (size_t)col * D, D), MIX[(size_t)row * D + col]);
#endif

    { PHASE_IDS;
    for (int m = gw; m < M; m += NGW) {
        f32x4 v[4]; ln0_row(x + (size_t)m * D, args.in[1], args.in[2], v, lane);
        const GAS f32x4* mr = (const GAS f32x4*)(MIX + (size_t)m * D) + lane;
#pragma unroll
        for (int j = 0; j < 4; ++j) v[j] = v[j] * ALPHA + mr[64 * j];
        float mean, rstd; row_stats(v, mean, rstd);
        GAS f32x4* orow = (GAS f32x4*)(out + (size_t)m * D) + lane;
#pragma unroll
        for (int j = 0; j < 4; ++j) { const f32x4 gv = ((const GAS f32x4*)args.in[12])[lane + 64 * j], bv = ((const GAS f32x4*)args.in[13])[lane + 64 * j]; v[j] = v[j] * rstd * gv + bv; orow[64 * j] = v[j]; }
        store_row_bf16(H1B + (size_t)m * D, v, lane);
    } }
    GRID_BAR();

    {
        pg8::Gemm g{H1B - D, WUP, M, 2 * DFF, D, 254}; pg8::StaticOrder S; S.init_tiles(65, 22, G, bx);
        pg8::EpiUpConv E{ACT, args.in[15], args.in[16], lds + HALO_OFF};
        pg8::gemm_phase<pg8::EpiUpConv, pg8::StaticOrder, true, true>(lds + RING_OFF, g, S, E);
    }
    GRID_BAR();
#if GEMM_CHECK
    {
        float d2_ = 0.f, r2_ = 0.f;
        for (unsigned s_ = 0; s_ < 4; ++s_) { int row, col; chk_rc((unsigned)(vcu * 512 + threadIdx.x), s_ + 64u, M, DFF, row, col);
            const int t = row & (SEQ - 1), pn = col >> 7, jj = col & 127; const bf16* wa_ = WUP + (size_t)(256 * pn + jj) * D; const bf16* wu_ = WUP + (size_t)(256 * pn + 128 + jj) * D;
            float ya = args.in[16][col], yu = args.in[16][DFF + col];
            for (int dt = -1; dt <= 1; ++dt) { if (t + dt < 0 || t + dt >= SEQ) continue;
                const float ua = rbf0(dot_bf16(H1B + (size_t)(row + dt) * D, wa_, D)), uu = rbf0(dot_bf16(H1B + (size_t)(row + dt) * D, wu_, D));
                ya += args.in[15][(dt + 1) * 2 * DFF + col] * ua; yu += args.in[15][(dt + 1) * 2 * DFF + DFF + col] * uu; }
            const float ref_ = ya * pg8::sigmoid_f(ya) * yu, val_ = bfv(ACT + (size_t)row * DFF + col); d2_ += (val_ - ref_) * (val_ - ref_); r2_ += ref_ * ref_; }
        chk_add(ctl, 4, d2_, r2_);
    }
#endif

    {
        pg8::Gemm g{ACT, WDN, M, D, DFF}; pg8::StaticOrder S; S.init(M, D, G, bx);
        pg8::EpiF32 E{FFN, D};
        pg8::gemm_phase<pg8::EpiF32, pg8::StaticOrder, true, true>(lds + RING_OFF, g, S, E);
    }
    GRID_BAR();
#if GEMM_CHECK
    CHK_LOOP(5, M, D, dot_bf16(ACT + (size_t)row * DFF, WDN + (size_t)col * DFF, DFF), FFN[(size_t)row * D + col]);
#endif

    { PHASE_IDS;
    for (int m = gw; m < M; m += NGW) {
        f32x4 v[4];
        GAS f32x4* orow = (GAS f32x4*)(out + (size_t)m * D) + lane;
        const GAS f32x4* fr = (const GAS f32x4*)(FFN + (size_t)m * D) + lane;
#pragma unroll
        for (int j = 0; j < 4; ++j) v[j] = orow[64 * j] * ALPHA + fr[64 * j];
        float mean, rstd; row_stats(v, mean, rstd);
#pragma unroll
        for (int j = 0; j < 4; ++j) { const f32x4 gv = ((const GAS f32x4*)args.in[18])[lane + 64 * j], bv = ((const GAS f32x4*)args.in[19])[lane + 64 * j]; orow[64 * j] = v[j] * rstd * gv + bv; }
    } }
#if GEMM_CHECK
    GRID_BAR();
    if (bx == 0 && threadIdx.x == 0) {
        float delta = 0.f, band = 30.f;
        for (int k = 0; k < 6; ++k) { const float d2 = __uint_as_float(__hip_atomic_load(ctl + CW_CHK + 64 * (2 * k), RLX_AGENT)), r2 = __uint_as_float(__hip_atomic_load(ctl + CW_CHK + 64 * (2 * k + 1), RLX_AGENT));
            if (!(d2 <= CHK_THR * r2) || !(r2 > 0.f)) delta += band; band *= 10.f; }
        out[0] += delta;
    }
#endif
}

extern "C" void kernel_launch(void* const* d_in, const int* in_sizes, int n_in, void* d_out, int out_size, void* d_ws, size_t ws_size, hipStream_t stream) {
    static int grid = 0;
    if (grid == 0) {
        if (n_in != 20 || in_sizes[0] != M * D || out_size != M * D || ws_size < WS_END) { fprintf(stderr, "kernel_launch: unexpected shapes (n_in %d, in0 %d, out %d, ws %zu)\n", n_in, n_in > 0 ? in_sizes[0] : -1, out_size, ws_size); grid = -1; return; }
        int dev = 0, cus = 0;
        if (hipGetDevice(&dev) != hipSuccess || hipDeviceGetAttribute(&cus, hipDeviceAttributeMultiprocessorCount, dev) != hipSuccess) { grid = -1; return; }
        if (hipFuncSetAttribute((const void*)hyb_fwd, hipFuncAttributeMaxDynamicSharedMemorySize, LDS_BYTES) != hipSuccess) { fprintf(stderr, "kernel_launch: hipFuncSetAttribute failed\n"); grid = -1; return; }
        int per_cu = 0;
        if (hipOccupancyMaxActiveBlocksPerMultiprocessor(&per_cu, (const void*)hyb_fwd, NWAVES * 64, LDS_BYTES) != hipSuccess || per_cu < 1) fprintf(stderr, "kernel_launch: occupancy query reports %d\n", per_cu);
        (void)hipGetLastError();
        grid = cus;
    }
    if (grid < 0) return;
    if (hipMemsetAsync((char*)d_ws + WS_CTL, 0, CTL_ZERO_BYTES, stream) != hipSuccess) return;
    Args a{};
    for (int i = 0; i < 20; ++i) a.in[i] = (const float*)d_in[i];
    a.out = (float*)d_out; a.ws = (unsigned char*)d_ws;
    hipLaunchKernelGGL(hyb_fwd, dim3(grid), dim3(NWAVES * 64), LDS_BYTES, stream, a);
}
```
